# Optimizing an MI355X kernel written in HIP

```python
import jax, jax.numpy as jnp
from jax import lax
import numpy as np

D_MODEL = 2048
BATCH = 8
SEQ = 2048
DEPTH = 1

HEAD_DIM = 64
N_Q_HEADS = 32
N_KV_HEADS = 4
GROUP = N_Q_HEADS // N_KV_HEADS
WINDOW = 128
BLOCK = 128
D_ATTN = N_Q_HEADS * HEAD_DIM
D_KV = N_KV_HEADS * HEAD_DIM
D_RNN = 2560
N_RNN_BLOCKS = 16
RNN_BLOCK_W = D_RNN // N_RNN_BLOCKS
RNN_CONV_W = 4
LRU_C = 8.0
D_FF = 3 * D_MODEL
FFN_CONV_W = 3
LN_EPS = 1e-5
ALPHA = (2 * DEPTH) ** 0.25
BETA = (8 * DEPTH) ** -0.25
SPLIT_SIZES = (D_ATTN, D_KV, D_KV, D_RNN, D_RNN, 2 * D_MODEL)
SPLIT_POINTS = tuple(int(s) for s in np.cumsum(SPLIT_SIZES)[:-1])
D_IN = int(sum(SPLIT_SIZES))
V_START = D_ATTN + D_KV

kernel_name = "hybrid_swa_rglru_gated_merge_deepnorm"


def alibi_slopes(n_heads):
    h = np.arange(1, n_heads + 1, dtype=np.float32)
    return jnp.asarray(2.0 ** (-8.0 * h / n_heads), dtype=jnp.float32)


def layer_norm(x, g, b):
    x32 = x.astype(jnp.float32)
    mu = jnp.mean(x32, axis=-1, keepdims=True)
    var = jnp.mean(jnp.square(x32 - mu), axis=-1, keepdims=True)
    y = (x32 - mu) * lax.rsqrt(var + LN_EPS) * g.astype(jnp.float32) + b.astype(jnp.float32)
    return y.astype(x.dtype)


def causal_dwconv(x, w, b):
    width = w.shape[0]
    s = x.shape[1]
    xp = jnp.pad(x, ((0, 0), (width - 1, 0), (0, 0)))
    y = sum(xp[:, k:k + s] * w[k] for k in range(width))
    return y + b


def sliding_window_attention(q, k, v, sinks):
    bsz, s = q.shape[0], q.shape[1]
    nb = s // BLOCK
    qb = q.reshape(bsz, nb, BLOCK, N_KV_HEADS, GROUP, HEAD_DIM)

    def band(t):
        tb = t.reshape(bsz, nb, BLOCK, N_KV_HEADS, HEAD_DIM)
        prev = jnp.pad(tb, ((0, 0), (1, 0), (0, 0), (0, 0), (0, 0)))[:, :-1]
        return jnp.concatenate([prev, tb], axis=2)

    kb, vb = band(k), band(v)
    scores = jnp.einsum('bnqhgd,bnkhd->bhgnqk', qb, kb).astype(jnp.float32) * (HEAD_DIM ** -0.5)
    qi = jnp.arange(BLOCK)[:, None]
    kj = jnp.arange(2 * BLOCK)[None, :]
    dist = BLOCK + qi - kj
    blk = jnp.arange(nb)[:, None, None]
    key_pos = (blk - 1) * BLOCK + kj
    valid = (dist >= 0) & (dist < WINDOW) & (key_pos >= 0)
    slopes = alibi_slopes(N_Q_HEADS).reshape(N_KV_HEADS, GROUP, 1, 1, 1)
    scores = scores - slopes * dist.astype(jnp.float32)
    scores = jnp.where(valid, scores, -jnp.inf)
    sink = sinks.astype(jnp.float32).reshape(N_KV_HEADS, GROUP, 1, 1, 1)
    m = jnp.maximum(jnp.max(scores, axis=-1, keepdims=True), sink)
    p = jnp.exp(scores - m)
    denom = jnp.sum(p, axis=-1, keepdims=True) + jnp.exp(sink - m)
    p = (p / denom).astype(v.dtype)
    o = jnp.einsum('bhgnqk,bnkhd->bnqhgd', p, vb)
    return o.reshape(bsz, s, D_ATTN)


def rg_lru(x, w_a, b_a, w_i, b_i, lam):
    bsz, s, _ = x.shape
    xb = x.reshape(bsz, s, N_RNN_BLOCKS, RNN_BLOCK_W)
    r = jax.nn.sigmoid(jnp.einsum('bsnc,ncd->bsnd', xb, w_a).reshape(bsz, s, D_RNN) + b_a)
    i = jax.nn.sigmoid(jnp.einsum('bsnc,ncd->bsnd', xb, w_i).reshape(bsz, s, D_RNN) + b_i)
    log_a = -LRU_C * r.astype(jnp.float32) * jax.nn.softplus(-lam.astype(jnp.float32))
    a = jnp.exp(log_a)
    u = jnp.sqrt(-jnp.expm1(2.0 * log_a)) * (i * x).astype(jnp.float32)

    def combine(left, right):
        a_l, b_l = left
        a_r, b_r = right
        return a_l * a_r, a_r * b_l + b_r

    _, h = lax.associative_scan(combine, (a, u), axis=1)
    return h.astype(x.dtype)


def setup_inputs(seed: int = 0) -> dict:
    key = jax.random.key(seed)
    ks = jax.random.split(key, 24)
    f32 = jnp.float32
    L = DEPTH
    nrm = lambda k, shape, scale: jax.random.normal(k, shape, f32) * scale
    x = jax.random.normal(ks[0], (BATCH, SEQ, D_MODEL), f32)
    w_in = nrm(ks[1], (L, D_MODEL, D_IN), D_MODEL ** -0.5)
    w_in = w_in.at[:, :, V_START:V_START + D_KV].multiply(BETA)
    b_gate = nrm(ks[2], (L, 2 * D_MODEL), 0.1)
    rnn_conv_w = nrm(ks[3], (L, RNN_CONV_W, D_RNN), RNN_CONV_W ** -0.5)
    rnn_conv_b = nrm(ks[4], (L, D_RNN), 0.02)
    lru_wa = nrm(ks[5], (L, N_RNN_BLOCKS, RNN_BLOCK_W, RNN_BLOCK_W), RNN_BLOCK_W ** -0.5)
    lru_ba = nrm(ks[6], (L, D_RNN), 0.02)
    lru_wi = nrm(ks[7], (L, N_RNN_BLOCKS, RNN_BLOCK_W, RNN_BLOCK_W), RNN_BLOCK_W ** -0.5)
    lru_bi = nrm(ks[8], (L, D_RNN), 0.02)
    a_c = jax.random.uniform(ks[9], (L, D_RNN), f32, minval=0.9, maxval=0.999)
    a0 = a_c ** (1.0 / LRU_C)
    lru_lambda = jnp.log(a0) - jnp.log1p(-a0)
    attn_sinks = nrm(ks[10], (L, N_Q_HEADS), 0.5)
    w_attn_proj = nrm(ks[11], (L, D_ATTN, D_MODEL), BETA * D_ATTN ** -0.5)
    w_rnn_proj = nrm(ks[12], (L, D_RNN, D_MODEL), BETA * D_RNN ** -0.5)
    w_out = nrm(ks[13], (L, D_MODEL, D_MODEL), BETA * D_MODEL ** -0.5)
    ln1_g = 1.0 + nrm(ks[14], (L, D_MODEL), 0.02)
    ln1_b = nrm(ks[15], (L, D_MODEL), 0.02)
    ffn_w_up = nrm(ks[16], (L, D_MODEL, D_FF), D_MODEL ** -0.5)
    ffn_w_gate = nrm(ks[17], (L, D_MODEL, D_FF), D_MODEL ** -0.5)
    ffn_conv_w = nrm(ks[18], (L, FFN_CONV_W, D_FF), FFN_CONV_W ** -0.5)
    ffn_conv_b = nrm(ks[19], (L, D_FF), 0.02)
    ffn_w_down = nrm(ks[20], (L, D_FF, D_MODEL), BETA * D_FF ** -0.5)
    ln2_g = 1.0 + nrm(ks[21], (L, D_MODEL), 0.02)
    ln2_b = nrm(ks[22], (L, D_MODEL), 0.02)
    return {"x": x, "w_in": w_in, "b_gate": b_gate, "rnn_conv_w": rnn_conv_w,
            "rnn_conv_b": rnn_conv_b, "lru_wa": lru_wa, "lru_ba": lru_ba, "lru_wi": lru_wi,
            "lru_bi": lru_bi, "lru_lambda": lru_lambda, "attn_sinks": attn_sinks,
            "w_attn_proj": w_attn_proj, "w_rnn_proj": w_rnn_proj, "w_out": w_out,
            "ln1_g": ln1_g, "ln1_b": ln1_b, "ffn_w_up": ffn_w_up, "ffn_w_gate": ffn_w_gate,
            "ffn_conv_w": ffn_conv_w, "ffn_conv_b": ffn_conv_b, "ffn_w_down": ffn_w_down,
            "ln2_g": ln2_g, "ln2_b": ln2_b}


def reference(x, w_in, b_gate, rnn_conv_w, rnn_conv_b, lru_wa, lru_ba, lru_wi, lru_bi,
              lru_lambda, attn_sinks, w_attn_proj, w_rnn_proj, w_out, ln1_g, ln1_b,
              ffn_w_up, ffn_w_gate, ffn_conv_w, ffn_conv_b, ffn_w_down, ln2_g, ln2_b):
    bsz, s, _ = x.shape
    for l in range(DEPTH):
        proj = x @ w_in[l]
        q, k, v, rx, ry, gl = jnp.split(proj, SPLIT_POINTS, axis=-1)
        q = q.reshape(bsz, s, N_Q_HEADS, HEAD_DIM)
        k = k.reshape(bsz, s, N_KV_HEADS, HEAD_DIM)
        v = v.reshape(bsz, s, N_KV_HEADS, HEAD_DIM)
        y_attn = sliding_window_attention(q, k, v, attn_sinks[l]) @ w_attn_proj[l]
        rx = causal_dwconv(rx, rnn_conv_w[l], rnn_conv_b[l])
        hr = rg_lru(rx, lru_wa[l], lru_ba[l], lru_wi[l], lru_bi[l], lru_lambda[l])
        y_rnn = (hr * jax.nn.gelu(ry, approximate=True)) @ w_rnn_proj[l]
        g_attn, g_rnn = jnp.split(jax.nn.sigmoid(gl + b_gate[l]), 2, axis=-1)
        mix = (g_attn * y_attn + g_rnn * y_rnn) @ w_out[l]
        x = layer_norm(ALPHA * x + mix, ln1_g[l], ln1_b[l])
        up = x @ ffn_w_up[l]
        gate = causal_dwconv(x @ ffn_w_gate[l], ffn_conv_w[l], ffn_conv_b[l])
        f = (jax.nn.gelu(gate, approximate=True) * up) @ ffn_w_down[l]
        x = layer_norm(ALPHA * x + f, ln2_g[l], ln2_b[l])
    return x
```

```cpp
#include <hip/hip_runtime.h>
#include <hip/hip_cooperative_groups.h>
#include <cstdio>
#include <cstdint>
namespace cg = cooperative_groups;

#define LAS __attribute__((address_space(3)))
typedef unsigned short bf16_t;
typedef short bf16x8 __attribute__((ext_vector_type(8)));
typedef short s16x4 __attribute__((ext_vector_type(4)));
typedef float f32x4 __attribute__((ext_vector_type(4)));
typedef float f32x16 __attribute__((ext_vector_type(16)));
typedef unsigned u32x4 __attribute__((ext_vector_type(4)));
typedef unsigned u32x2 __attribute__((ext_vector_type(2)));

constexpr int M = 16384, DM = 2048, SEQ = 2048;
constexpr int DIN = 11776, PP = 7680  , GP = 4096  ;
constexpr int C_Q = 0, C_RY = 2048, C_K = 4608, C_V = 4864, C_RX = 5120;
constexpr int DRNN = 2560, DFF = 6144, KCAT = 4608;
constexpr float ALPHA = 1.189207115002721f;
constexpr float LN_EPS = 1e-5f;
constexpr float LOG2E = 1.4426950408889634f;

constexpr size_t MiB = 1u << 20;
constexpr size_t WS_LRU = 1 * MiB, WS_STASH = 3 * MiB, WS_WIN = 12 * MiB, WS_WCAT = 58 * MiB, WS_WOUT = 76 * MiB, WS_WUG = 84 * MiB, WS_WDN = 132 * MiB,
                 WS_XB = 156 * MiB, WS_PROJ = 220 * MiB, WS_END = 460 * MiB;
constexpr int NWAVES = 8, NTHREADS = 512;
constexpr int LDS_BYTES = 147456, XLDS_OFF = 131072;

__device__ __forceinline__ unsigned cvt_pk_bf16(float lo, float hi) { unsigned r; asm volatile("v_cvt_pk_bf16_f32 %0, %1, %2" : "=v"(r) : "v"(lo), "v"(hi)); return r; }
__device__ __forceinline__ float bf2f(unsigned short h) { return __uint_as_float(((unsigned)h) << 16); }
__device__ __forceinline__ float bflo(unsigned w) { return __uint_as_float(w << 16); }
__device__ __forceinline__ float bfhi(unsigned w) { return __uint_as_float(w & 0xffff0000u); }
__device__ __forceinline__ float fast_exp2(float x) { return __builtin_amdgcn_exp2f(x); }
__device__ __forceinline__ float fast_rcp(float x) { return __builtin_amdgcn_rcpf(x); }
__device__ __forceinline__ float sigmoidf_(float z) { return fast_rcp(1.0f + fast_exp2(-LOG2E * z)); }
__device__ __forceinline__ float gelu_tanh(float x) {
    const float u = x * (0.7978845608028654f + 0.035677408136300125f * x * x);
    return x * fast_rcp(1.0f + fast_exp2(-2.0f * LOG2E * u));
}
__device__ __forceinline__ int crow(int r, int hi) { return (r & 3) + 8 * (r >> 2) + 4 * hi; }
__device__ __forceinline__ float lane_from(float v, int src) { return __int_as_float(__builtin_amdgcn_ds_bpermute(src << 2, __float_as_int(v))); }

namespace pg8 {
constexpr int BM = 256, BK = 64, HALF = 128, HTB = HALF * BK * 2, STAGE_BYTES = 8 * HTB, NXCD = 8, WGM = 8;
__host__ __device__ __forceinline__ int lds_byte(int r, int c) { const int st = (r >> 4) * 2 + (c >> 5), rr = r & 15, cc = c & 31, ob = rr * 64 + cc * 2; return st * 1024 + (ob ^ (((ob >> 9) & 1) << 5)); }
__host__ __device__ __forceinline__ void stage_rc(int b, int& R, int& C) { const int st = b / 1024, sb = b % 1024, swz = sb ^ (((sb >> 9) & 1) << 5); R = (st >> 1) * 16 + swz / 64; C = (st & 1) * 32 + (swz % 64) / 2; }
__host__ __device__ __forceinline__ int perm32(int rho) { const int n = rho >> 4, i = rho & 15; return 8 * (i >> 2) + 4 * n + (i & 3); }

struct Unit { int pm, pn; };
struct Gemm { const bf16_t* A; const bf16_t* Bt; int lda, ldb, K; };

struct StaticOrder {
    int nM, nN, nwg, G, c;
    __device__ void init(int M_, int N_, int G_, int c_) { nM = M_ / BM; nN = N_ / BM; nwg = nM * nN; G = G_; c = c_; }
    __device__ bool next(int i, Unit& u) const {
        const long L = (long)i * G + c; if (L >= nwg) return false;
        int wgid = (int)L; { const int q = nwg / NXCD, r = nwg % NXCD, xcd = wgid % NXCD, off = wgid / NXCD; wgid = (xcd < r ? xcd * (q + 1) : r * (q + 1) + (xcd - r) * q) + off; }
        const int nig = WGM * nN, gid = wgid / nig, fm = gid * WGM, gsz = (nM - fm) < WGM ? (nM - fm) : WGM;
        u.pm = fm + ((wgid % nig) % gsz); u.pn = (wgid % nig) / gsz; return true;
    }
};

typedef f32x4 Acc[2][2][4][2];

struct EpiProj {
    static constexpr bool PERM = true, HAS_MID = false;
    bf16_t* proj; bf16_t* gate; const float* bgate;
    __device__ __forceinline__ void mid(Acc&, const Unit&, int, int, int, int) const {}
    __device__ __forceinline__ void operator()(Acc& acc, const Unit& u, int wr, int wc, int fr, int fq, LAS unsigned char*, int) const {
        const int row0 = u.pm * BM + wr * 64 + fr;
        const bool isg = u.pn >= 30;
        bf16_t* base = isg ? gate : proj; const int ldc = isg ? GP : PP;
        const int col0 = (isg ? (u.pn - 30) : u.pn) * BM + wc * 32 + 8 * fq;
        f32x4 bv[2][2];
#pragma unroll
        for (int bj = 0; bj < 2; ++bj)
#pragma unroll
            for (int n = 0; n < 2; ++n) bv[bj][n] = isg ? *(const f32x4*)(bgate + col0 + bj * HALF + 4 * n) : (f32x4){0.f, 0.f, 0.f, 0.f};
#pragma unroll
        for (int ai = 0; ai < 2; ++ai)
#pragma unroll
            for (int m = 0; m < 4; ++m) { bf16_t* rowp = base + (size_t)(row0 + ai * HALF + m * 16) * ldc + col0;
#pragma unroll
                for (int bj = 0; bj < 2; ++bj) { f32x4 v0 = acc[ai][bj][m][0] + bv[bj][0], v1 = acc[ai][bj][m][1] + bv[bj][1];
                    if (isg) {
#pragma unroll
                        for (int j = 0; j < 4; ++j) { v0[j] = sigmoidf_(v0[j]); v1[j] = sigmoidf_(v1[j]); } }
                    u32x4 w; w.x = cvt_pk_bf16(v0[0], v0[1]); w.y = cvt_pk_bf16(v0[2], v0[3]); w.z = cvt_pk_bf16(v1[0], v1[1]); w.w = cvt_pk_bf16(v1[2], v1[3]);
                    *(u32x4*)(rowp + bj * HALF) = w; } }
    }
};

struct EpiMerge {
    static constexpr bool PERM = true, HAS_MID = true;
    const bf16_t* gate; bf16_t* out; int mid_t;
    __device__ __forceinline__ void mid(Acc& acc, const Unit& u, int wr, int wc, int fr, int fq) const {
        const int row0 = u.pm * BM + wr * 64 + fr, col0 = u.pn * BM + wc * 32 + 8 * fq;
#pragma unroll
        for (int ai = 0; ai < 2; ++ai)
#pragma unroll
            for (int m = 0; m < 4; ++m) { unsigned go = (unsigned)((row0 + ai * HALF + m * 16) * GP + col0) * 2u; asm volatile("" : "+v"(go)); const char* gp = (const char*)gate + go;
#pragma unroll
                for (int bj = 0; bj < 2; ++bj) { const u32x4 a = *(const u32x4*)(gp + bj * HALF * 2), r = *(const u32x4*)(gp + (2048 + bj * HALF) * 2);
                    f32x4 q0, q1;
                    q0[0] = bflo(a.x) * fast_rcp(bflo(r.x)); q0[1] = bfhi(a.x) * fast_rcp(bfhi(r.x)); q0[2] = bflo(a.y) * fast_rcp(bflo(r.y)); q0[3] = bfhi(a.y) * fast_rcp(bfhi(r.y));
                    q1[0] = bflo(a.z) * fast_rcp(bflo(r.z)); q1[1] = bfhi(a.z) * fast_rcp(bfhi(r.z)); q1[2] = bflo(a.w) * fast_rcp(bflo(r.w)); q1[3] = bfhi(a.w) * fast_rcp(bfhi(r.w));
                    acc[ai][bj][m][0] *= q0; acc[ai][bj][m][1] *= q1; asm volatile("" ::: "memory"); __builtin_amdgcn_sched_barrier(0); } }
    }
    __device__ __forceinline__ void operator()(Acc& acc, const Unit& u, int wr, int wc, int fr, int fq, LAS unsigned char*, int) const {
        const int row0 = u.pm * BM + wr * 64 + fr, col0 = u.pn * BM + wc * 32 + 8 * fq;
#pragma unroll
        for (int ai = 0; ai < 2; ++ai)
#pragma unroll
            for (int m = 0; m < 4; ++m) { const unsigned ro = (unsigned)(row0 + ai * HALF + m * 16);
#pragma unroll
                for (int bj = 0; bj < 2; ++bj) { const u32x4 r = *(const u32x4*)((const char*)gate + (ro * GP + 2048 + col0 + bj * HALF) * 2u);
                    const f32x4 v0 = acc[ai][bj][m][0], v1 = acc[ai][bj][m][1];
                    u32x4 w; w.x = cvt_pk_bf16(v0[0] * bflo(r.x), v0[1] * bfhi(r.x)); w.y = cvt_pk_bf16(v0[2] * bflo(r.y), v0[3] * bfhi(r.y));
                    w.z = cvt_pk_bf16(v1[0] * bflo(r.z), v1[1] * bfhi(r.z)); w.w = cvt_pk_bf16(v1[2] * bflo(r.w), v1[3] * bfhi(r.w));
                    *(u32x4*)((char*)out + (ro * DM + col0 + bj * HALF) * 2u) = w; }
                asm volatile("" ::: "memory"); }
    }
};

struct EpiRes {
    static constexpr bool PERM = false, HAS_MID = false;
    const float* base; float* out;
    __device__ __forceinline__ void mid(Acc&, const Unit&, int, int, int, int) const {}
    __device__ __forceinline__ void operator()(Acc& acc, const Unit& u, int wr, int wc, int fr, int fq, LAS unsigned char*, int) const {
        const int col0 = u.pn * BM + wc * 32 + 4 * fq;
#pragma unroll
        for (int ai = 0; ai < 2; ++ai)
#pragma unroll
            for (int m = 0; m < 4; ++m) { const size_t off = (size_t)(u.pm * BM + ai * HALF + wr * 64 + m * 16 + fr) * DM + col0;
#pragma unroll
                for (int bj = 0; bj < 2; ++bj)
#pragma unroll
                    for (int n = 0; n < 2; ++n) { const f32x4 bs = *(const f32x4*)(base + off + bj * HALF + n * 16); *(f32x4*)(out + off + bj * HALF + n * 16) = bs * ALPHA + acc[ai][bj][m][n]; }
                if (m & 1) asm volatile("" ::: "memory"); }
    }
};

struct EpiGlu {
    static constexpr bool PERM = true, HAS_MID = false;
    bf16_t* act; const float* cw; const float* cb; float* gtail; float* ghead; float* uhead;
    __device__ __forceinline__ void mid(Acc&, const Unit&, int, int, int, int) const {}
    __device__ __forceinline__ void operator()(Acc& acc, const Unit& u, int wr, int wc, int fr, int fq, LAS unsigned char* xl, int lane) const {
        const int chl = wc * 32 + 8 * fq, ch0 = u.pn * 128 + chl;
        if (fr >= 14) {
#pragma unroll
            for (int ai = 0; ai < 2; ++ai)
#pragma unroll
                for (int n = 0; n < 2; ++n) *(LAS f32x4*)(xl + (((ai * 2 + wr) * 2 + (fr - 14)) * 128 + chl + 4 * n) * 4) = acc[ai][1][3][n];
            if (wr == 1) {
#pragma unroll
                for (int n = 0; n < 2; ++n) *(f32x4*)(gtail + ((size_t)(u.pm * 2 + (fr - 14))) * DFF + ch0 + 4 * n) = acc[1][1][3][n]; }
        }
        if (fr < 2 && wr == 0) {
#pragma unroll
            for (int n = 0; n < 2; ++n) { *(f32x4*)(ghead + ((size_t)(u.pm * 2 + fr)) * DFF + ch0 + 4 * n) = acc[0][1][0][n]; *(f32x4*)(uhead + ((size_t)(u.pm * 2 + fr)) * DFF + ch0 + 4 * n) = acc[0][0][0][n]; }
        }
        f32x4 w0[2], w1[2], w2[2], bb[2];
#pragma unroll
        for (int n = 0; n < 2; ++n) { w0[n] = *(const f32x4*)(cw + ch0 + 4 * n); w1[n] = *(const f32x4*)(cw + DFF + ch0 + 4 * n); w2[n] = *(const f32x4*)(cw + 2 * DFF + ch0 + 4 * n); bb[n] = *(const f32x4*)(cb + ch0 + 4 * n); }
        asm volatile("s_waitcnt lgkmcnt(0)" ::: "memory"); __builtin_amdgcn_s_barrier(); asm volatile("" ::: "memory");
        const int l1 = lane - 1, l2 = lane - 2, l15 = lane + 15, l14 = lane + 14;
#pragma unroll
        for (int ai = 0; ai < 2; ++ai) {
            f32x4 h62[2], h63[2];
            const bool hz = (wr == 0 && ai == 0); const int hb = (wr == 1) ? (ai * 2) : ((ai - 1) * 2 + 1);
#pragma unroll
            for (int n = 0; n < 2; ++n) { if (hz) { h62[n] = (f32x4){0.f, 0.f, 0.f, 0.f}; h63[n] = h62[n]; } else { h62[n] = *(const LAS f32x4*)(xl + ((hb * 2 + 0) * 128 + chl + 4 * n) * 4); h63[n] = *(const LAS f32x4*)(xl + ((hb * 2 + 1) * 128 + chl + 4 * n) * 4); } }
#pragma unroll
            for (int m = 0; m < 4; ++m) { u32x4 w; float o[8];
#pragma unroll
                for (int n = 0; n < 2; ++n)
#pragma unroll
                    for (int j = 0; j < 4; ++j) { const float g = acc[ai][1][m][n][j];
                        float a1 = lane_from(g, l1), a2 = lane_from(g, l2), b1, b2;
                        if (m == 0) { b1 = h63[n][j]; b2 = (fr == 0) ? h62[n][j] : h63[n][j]; }
                        else { const float gp = acc[ai][1][m - 1][n][j]; b1 = lane_from(gp, l15); b2 = lane_from(gp, l14); }
                        const float p1 = (fr >= 1) ? a1 : b1, p2 = (fr >= 2) ? a2 : b2;
                        const float cv = w0[n][j] * p2 + w1[n][j] * p1 + w2[n][j] * g + bb[n][j];
                        o[n * 4 + j] = gelu_tanh(cv) * acc[ai][0][m][n][j]; }
                w.x = cvt_pk_bf16(o[0], o[1]); w.y = cvt_pk_bf16(o[2], o[3]); w.z = cvt_pk_bf16(o[4], o[5]); w.w = cvt_pk_bf16(o[6], o[7]);
                *(u32x4*)(act + (size_t)(u.pm * BM + ai * HALF + wr * 64 + m * 16 + fr) * DFF + ch0) = w; }
        }
    }
};

template <class Epi>
__device__ __forceinline__ void gemm_phase(LAS unsigned char* lds, const Gemm g, const StaticOrder& S, const Epi& E) {
    const int tid = threadIdx.x, wid = __builtin_amdgcn_readfirstlane(tid >> 6), lane = tid & 63, wr = wid >> 2, wc = wid & 3, fr = lane & 15, fq = lane >> 4;
    const int K = g.K, nt = K / BK;
    unsigned voffA[2], voffB[2];
#pragma unroll
    for (int i = 0; i < 2; ++i) { int R, C; stage_rc(tid * 16 + i * 8192, R, C); const int Rb = Epi::PERM ? ((R & ~31) + perm32(R & 31)) : R;
        voffA[i] = (unsigned)(R * g.lda + C) * 2u; voffB[i] = (unsigned)(Rb * g.ldb + C) * 2u; }
    const size_t kstep = (size_t)(BK * 2);
    const size_t hstepA = (size_t)HALF * g.lda * 2, hstepB = (size_t)HALF * g.ldb * 2;
    const size_t tstepA = 2 * hstepA, tstepB = 2 * hstepB;
    const unsigned ldsw = (unsigned)wid * 1024u;
    const int aoff = lds_byte(wr * 64 + fr, fq * 8), boff = lds_byte(wc * 32 + fr, fq * 8);
#define PG8_SA(b, h) (((b) * 2 + (h)) * HTB)
#define PG8_SB(b, h) ((4 + (b) * 2 + (h)) * HTB)
#define PG8_STAGE(bufoff, gbase, voff) do { _Pragma("unroll") for (int _i = 0; _i < 2; ++_i) \
        __builtin_amdgcn_global_load_lds((const unsigned*)((const char*)(gbase) + (voff)[_i]), (LAS unsigned*)(lds + (bufoff) + ldsw + _i * 8192), 16, 0, 0); } while (0)
#define PG8_LDA(dst, b, h) do { _Pragma("unroll") for (int m = 0; m < 4; ++m) _Pragma("unroll") for (int k = 0; k < 2; ++k) dst[m][k] = *(const LAS bf16x8*)(lds + PG8_SA(b, h) + aoff + m * 2048 + k * 1024); } while (0)
#define PG8_LDB(dst, b, h) do { _Pragma("unroll") for (int n = 0; n < 2; ++n) _Pragma("unroll") for (int k = 0; k < 2; ++k) dst[n][k] = *(const LAS bf16x8*)(lds + PG8_SB(b, h) + boff + n * 2048 + k * 1024); } while (0)
#define PG8_MMA(ai, bj, At, Bt) do { __builtin_amdgcn_s_setprio(1); _Pragma("unroll") for (int m = 0; m < 4; ++m) _Pragma("unroll") for (int n = 0; n < 2; ++n) _Pragma("unroll") for (int k = 0; k < 2; ++k) \
        acc[ai][bj][m][n] = __builtin_amdgcn_mfma_f32_16x16x32_bf16(Bt[n][k], At[m][k], acc[ai][bj][m][n], 0, 0, 0); __builtin_amdgcn_s_setprio(0); } while (0)
#define PG8_WAIT_V(n) asm volatile("s_waitcnt vmcnt(" #n ")" ::: "memory")
#define PG8_WAIT_L(n) asm volatile("s_waitcnt lgkmcnt(" #n ")" ::: "memory")
#define PG8_BAR __builtin_amdgcn_s_barrier()
#define PG8_SCHED __builtin_amdgcn_sched_barrier(0)
    Unit cur, nxt; int ui = 0;
    if (!S.next(0, cur)) return;
    Acc acc;
#pragma unroll
    for (int a = 0; a < 2; ++a)
#pragma unroll
        for (int b = 0; b < 2; ++b)
#pragma unroll
            for (int m = 0; m < 4; ++m)
#pragma unroll
                for (int n = 0; n < 2; ++n) acc[a][b][m][n] = (f32x4){0.f, 0.f, 0.f, 0.f};
    bf16x8 At[4][2], B0[2][2], B1[2][2];
    const char* cA = (const char*)g.A + (size_t)cur.pm * tstepA; const char* cB = (const char*)g.Bt + (size_t)cur.pn * tstepB;
    PG8_STAGE(PG8_SB(0, 0), cB, voffB); PG8_STAGE(PG8_SB(0, 1), cB + hstepB, voffB); PG8_STAGE(PG8_SA(0, 0), cA, voffA); PG8_STAGE(PG8_SA(0, 1), cA + hstepA, voffA);
    if (wr == 1) PG8_BAR;
    PG8_WAIT_V(2); PG8_BAR;
    PG8_STAGE(PG8_SB(1, 0), cB + kstep, voffB); PG8_STAGE(PG8_SA(1, 0), cA + kstep, voffA); PG8_STAGE(PG8_SB(1, 1), cB + hstepB + kstep, voffB);
    PG8_WAIT_V(6); PG8_BAR;
    for (;;) {
        const bool has_next = S.next(ui + 1, nxt);
        const char* nA = has_next ? (const char*)g.A + (size_t)nxt.pm * tstepA : cA; const char* nB = has_next ? (const char*)g.Bt + (size_t)nxt.pn * tstepB : cB;
        for (int t = 0; t < nt; t += 2) {
            const bool last = (t == nt - 2);
            const char* a1 = cA + (size_t)(t + 1) * kstep;
            const char* a2 = last ? nA : cA + (size_t)(t + 2) * kstep; const char* b2 = last ? nB : cB + (size_t)(t + 2) * kstep;
            const char* a3 = a2 + kstep; const char* b3 = b2 + kstep;
            if constexpr (Epi::HAS_MID) { if (t == E.mid_t) { PG8_SCHED; E.mid(acc, cur, wr, wc, fr, fq); PG8_SCHED; } }
            PG8_LDB(B0, 0, 0); PG8_LDB(B1, 0, 1); PG8_SCHED; PG8_LDA(At, 0, 0); PG8_STAGE(PG8_SA(1, 1), a1 + hstepA, voffA);
            PG8_WAIT_V(8); PG8_WAIT_L(0); PG8_BAR; PG8_MMA(0, 0, At, B0); PG8_MMA(0, 1, At, B1); PG8_BAR; PG8_SCHED;
            PG8_LDA(At, 0, 1); PG8_STAGE(PG8_SB(0, 0), b2, voffB); PG8_STAGE(PG8_SB(0, 1), b2 + hstepB, voffB); PG8_STAGE(PG8_SA(0, 0), a2, voffA);
            PG8_WAIT_V(8); PG8_WAIT_L(0); PG8_BAR; PG8_MMA(1, 0, At, B0); PG8_MMA(1, 1, At, B1); PG8_BAR; PG8_SCHED;
            PG8_LDB(B0, 1, 0); PG8_LDB(B1, 1, 1); PG8_SCHED; PG8_LDA(At, 1, 0); PG8_STAGE(PG8_SA(0, 1), a2 + hstepA, voffA);
            PG8_WAIT_V(8); PG8_WAIT_L(0); PG8_BAR; PG8_MMA(0, 0, At, B0); PG8_MMA(0, 1, At, B1); PG8_BAR; PG8_SCHED;
            PG8_LDA(At, 1, 1); PG8_STAGE(PG8_SB(1, 0), b3, voffB); PG8_STAGE(PG8_SB(1, 1), b3 + hstepB, voffB); PG8_STAGE(PG8_SA(1, 0), a3, voffA);
            PG8_WAIT_V(8); PG8_WAIT_L(0); PG8_BAR; PG8_MMA(1, 0, At, B0); PG8_MMA(1, 1, At, B1); PG8_BAR; PG8_SCHED;
        }
        if (wr == 0) PG8_BAR;
        E(acc, cur, wr, wc, fr, fq, lds + XLDS_OFF, lane);
        if (!has_next) break;
#pragma unroll
        for (int a = 0; a < 2; ++a)
#pragma unroll
            for (int b = 0; b < 2; ++b)
#pragma unroll
                for (int m = 0; m < 4; ++m)
#pragma unroll
                    for (int n = 0; n < 2; ++n) acc[a][b][m][n] = (f32x4){0.f, 0.f, 0.f, 0.f};
        cur = nxt; cA = nA; cB = nB; ++ui;
        if (wr == 1) PG8_BAR;
    }
    PG8_WAIT_V(0);
    PG8_BAR;
#undef PG8_SA
#undef PG8_SB
#undef PG8_STAGE
#undef PG8_LDA
#undef PG8_LDB
#undef PG8_MMA
#undef PG8_WAIT_V
#undef PG8_WAIT_L
#undef PG8_BAR
#undef PG8_SCHED
}
}

struct Args {
    const float* x; const float* w_in; const float* b_gate; const float* rnn_conv_w; const float* rnn_conv_b; const float* lru_wa; const float* lru_ba; const float* lru_wi; const float* lru_bi;
    const float* lru_lambda; const float* attn_sinks; const float* w_attn_proj; const float* w_rnn_proj; const float* w_out; const float* ln1_g; const float* ln1_b;
    const float* ffn_w_up; const float* ffn_w_gate; const float* ffn_conv_w; const float* ffn_conv_b; const float* ffn_w_down; const float* ln2_g; const float* ln2_b;
    float* out; unsigned char* ws; int ph_lo, ph_hi;
};

__device__ __forceinline__ void tr_item(const float* W, int N, bf16_t* WT, int ldt, int koff, int drow, LAS float* scr, int k0, int n0, int lane) {
#pragma unroll 8
    for (int i = 0; i < 32; ++i) { const int kk = 2 * i + (lane >> 5); scr[kk * 33 + (lane & 31)] = W[(size_t)(k0 + kk) * N + n0 + (lane & 31)]; }
    asm volatile("s_waitcnt lgkmcnt(0)" ::: "memory");
    const int c = lane & 7;
#pragma unroll
    for (int j = 0; j < 4; ++j) { const int n = (lane >> 3) + 8 * j; const LAS float* s = scr + (8 * c) * 33 + n;
        u32x4 o; o.x = cvt_pk_bf16(s[0 * 33], s[1 * 33]); o.y = cvt_pk_bf16(s[2 * 33], s[3 * 33]); o.z = cvt_pk_bf16(s[4 * 33], s[5 * 33]); o.w = cvt_pk_bf16(s[6 * 33], s[7 * 33]);
        *(u32x4*)(WT + (size_t)(drow + n) * ldt + koff + k0 + 8 * c) = o; }
    asm volatile("s_waitcnt lgkmcnt(0)" ::: "memory");
}
__device__ __forceinline__ int win_row(int n0) {
    if (n0 < 2048) return n0;
    if (n0 < 2304) return C_K + (n0 - 2048);
    if (n0 < 2560) return C_V + (n0 - 2304);
    if (n0 < 5120) return C_RX + (n0 - 2560);
    if (n0 < 7680) return C_RY + (n0 - 5120);
    return n0;
}
__device__ __forceinline__ void prologue(const Args& a, LAS unsigned char* lds, int gw, int NGW, int wid, int lane, int gtid, int NGT) {
    unsigned char* ws = a.ws;
    bf16_t* win = (bf16_t*)(ws + WS_WIN); bf16_t* wcat = (bf16_t*)(ws + WS_WCAT); bf16_t* wout = (bf16_t*)(ws + WS_WOUT); bf16_t* wug = (bf16_t*)(ws + WS_WUG); bf16_t* wdn = (bf16_t*)(ws + WS_WDN);
    LAS float* scr = (LAS float*)(lds + wid * 16384);
    constexpr int I_IN = 32 * 368, I_AP = 32 * 64, I_RP = 40 * 64, I_WO = 32 * 64, I_UP = 32 * 192, I_GT = 32 * 192, I_DN = 96 * 64;
    constexpr int NITEMS = I_IN + I_AP + I_RP + I_WO + I_UP + I_GT + I_DN;
    for (int it = gw; it < NITEMS; it += NGW) {
        int r = it;
        if (r < I_IN) { const int kb = r / 368, nb = r % 368; tr_item(a.w_in, DIN, win, 2048, 0, win_row(nb * 32), scr, kb * 64, nb * 32, lane); continue; } r -= I_IN;
        if (r < I_AP) { const int kb = r / 64, nb = r % 64; tr_item(a.w_attn_proj, 2048, wcat, KCAT, 0, nb * 32, scr, kb * 64, nb * 32, lane); continue; } r -= I_AP;
        if (r < I_RP) { const int kb = r / 64, nb = r % 64; tr_item(a.w_rnn_proj, 2048, wcat, KCAT, 2048, nb * 32, scr, kb * 64, nb * 32, lane); continue; } r -= I_RP;
        if (r < I_WO) { const int kb = r / 64, nb = r % 64; tr_item(a.w_out, 2048, wout, 2048, 0, nb * 32, scr, kb * 64, nb * 32, lane); continue; } r -= I_WO;
        if (r < I_UP) { const int kb = r / 192, nb = r % 192, n0 = nb * 32; tr_item(a.ffn_w_up, DFF, wug, 2048, 0, (n0 >> 7) * 256 + (n0 & 127), scr, kb * 64, n0, lane); continue; } r -= I_UP;
        if (r < I_GT) { const int kb = r / 192, nb = r % 192, n0 = nb * 32; tr_item(a.ffn_w_gate, DFF, wug, 2048, 0, (n0 >> 7) * 256 + 128 + (n0 & 127), scr, kb * 64, n0, lane); continue; } r -= I_GT;
        { const int kb = r / 64, nb = r % 64; tr_item(a.ffn_w_down, 2048, wdn, DFF, 0, nb * 32, scr, kb * 64, nb * 32, lane); }
    }
    bf16_t* xb = (bf16_t*)(ws + WS_XB);
    for (size_t i = (size_t)gtid; i < (size_t)M * DM / 8; i += NGT) { const f32x4 v0 = *(const f32x4*)(a.x + i * 8), v1 = *(const f32x4*)(a.x + i * 8 + 4);
        u32x4 o; o.x = cvt_pk_bf16(v0[0], v0[1]); o.y = cvt_pk_bf16(v0[2], v0[3]); o.z = cvt_pk_bf16(v1[0], v1[1]); o.w = cvt_pk_bf16(v1[2], v1[3]); *(u32x4*)(xb + i * 8) = o; }
    bf16_t* wat = (bf16_t*)(ws + WS_LRU); bf16_t* wit = wat + 16 * 160 * 160;
    for (int i = gtid; i < 2 * 16 * 160 * 160; i += NGT) { const int which = i / (16 * 160 * 160), e = i % (16 * 160 * 160), n = e / 25600, o = (e % 25600) / 160, k = e % 160;
        const float v = (which ? a.lru_wi : a.lru_wa)[(size_t)n * 25600 + k * 160 + o]; (which ? wit : wat)[e] = (bf16_t)(cvt_pk_bf16(v, 0.f) & 0xffffu); }
}

__device__ __forceinline__ void attn_unit(LAS unsigned char* lds, bf16_t* proj, const float* sinks, int unit, int tid, const int wid, int lane) {
    asm volatile("" : "+v"(tid), "+v"(lane));
    const int qb = unit & 15, g = (unit >> 4) & 3, b = unit >> 6;
    const int tok0 = b * SEQ + qb * 128;
    __syncthreads();
#pragma unroll
    for (int i = 0; i < 4; ++i) { const int c = tid + 512 * i, row = c >> 3, ch = c & 7;
        u32x4 kv = (u32x4){0u, 0u, 0u, 0u}, vv = kv;
        if (qb > 0 || row >= 128) { const bf16_t* p = proj + (size_t)(tok0 - 128 + row) * PP + g * 64 + ch * 8; kv = *(const u32x4*)(p + C_K); vv = *(const u32x4*)(p + C_V); }
        *(LAS u32x4*)(lds + row * 128 + ((ch ^ (row & 7)) << 4)) = kv;
        *(LAS u32x4*)(lds + 32768 + row * 128 + ch * 16) = vv; }
    __syncthreads();
    const int h = g * 8 + wid, q = lane & 31, hi = lane >> 5;
    const float slope2 = exp2f(-(float)(h + 1) * 0.25f) * LOG2E, sink2 = sinks[h] * LOG2E;
    constexpr float SC2 = 0.125f * LOG2E;
    for (int a = 0; a < 4; ++a) {
        bf16_t* qp = proj + (size_t)(tok0 + 32 * a + q) * PP + C_Q + h * 64;
        bf16x8 qf[4];
#pragma unroll
        for (int ds = 0; ds < 4; ++ds) qf[ds] = *(const bf16x8*)(qp + 16 * ds + 8 * hi);
        f32x16 s[5];
#pragma unroll
        for (int kt = 0; kt < 5; ++kt) { const int key = 32 * (a + kt) + q; f32x16 acc;
#pragma unroll
            for (int r = 0; r < 16; ++r) acc[r] = 0.f;
#pragma unroll
            for (int ds = 0; ds < 4; ++ds) { const bf16x8 kf = *(const LAS bf16x8*)(lds + key * 128 + (((2 * ds + hi) ^ (key & 7)) << 4)); acc = __builtin_amdgcn_mfma_f32_32x32x16_bf16(kf, qf[ds], acc, 0, 0, 0); }
            s[kt] = acc; __builtin_amdgcn_sched_barrier(0); }
        float mx = sink2;
        int qm = q - 4 * hi; asm volatile("" : "+v"(qm));
        const float tl = -slope2 * (float)(128 + qm);
#pragma unroll
        for (int kt = 0; kt < 5; ++kt) { const bool tile_ok = (qb > 0) || (a + kt >= 4);
#pragma unroll
            for (int r = 0; r < 16; ++r) { const int cc0 = (r & 3) + 8 * (r >> 2);
                bool valid = tile_ok;
                if (kt == 0) valid = valid && (cc0 > qm);
                if (kt == 4) valid = valid && (cc0 <= qm);
                const float v = valid ? fmaf(slope2, (float)(32 * kt + cc0), fmaf(s[kt][r], SC2, tl)) : -INFINITY; s[kt][r] = v; mx = fmaxf(mx, v); } }
        mx = fmaxf(mx, __shfl_xor(mx, 32));
        float sum = 0.f;
#pragma unroll
        for (int kt = 0; kt < 5; ++kt)
#pragma unroll
            for (int r = 0; r < 16; ++r) { const float p = fast_exp2(s[kt][r] - mx); s[kt][r] = p; sum += p; }
        sum += __shfl_xor(sum, 32);
        const float inv = 1.0f / (sum + fast_exp2(sink2 - mx));
        f32x16 o[2];
#pragma unroll
        for (int r = 0; r < 16; ++r) { o[0][r] = 0.f; o[1][r] = 0.f; }
#pragma unroll
        for (int kt = 0; kt < 5; ++kt)
#pragma unroll
            for (int s2 = 0; s2 < 2; ++s2) {
                u32x4 pw; pw.x = cvt_pk_bf16(s[kt][8 * s2 + 0], s[kt][8 * s2 + 1]); pw.y = cvt_pk_bf16(s[kt][8 * s2 + 2], s[kt][8 * s2 + 3]); pw.z = cvt_pk_bf16(s[kt][8 * s2 + 4], s[kt][8 * s2 + 5]); pw.w = cvt_pk_bf16(s[kt][8 * s2 + 6], s[kt][8 * s2 + 7]);
                const bf16x8 pa = __builtin_bit_cast(bf16x8, pw);
                const int keybase = 32 * (a + kt) + 16 * s2 + 4 * hi;
#pragma unroll
                for (int dt = 0; dt < 2; ++dt) {
                    LAS unsigned char* vp = lds + 32768 + (keybase + ((lane & 15) >> 2)) * 128 + (32 * dt + 16 * ((lane >> 4) & 1) + 4 * (lane & 3)) * 2;
                    const s16x4 lo = __builtin_amdgcn_ds_read_tr16_b64_v4i16((LAS s16x4*)vp), hh = __builtin_amdgcn_ds_read_tr16_b64_v4i16((LAS s16x4*)(vp + 8 * 128));
                    const bf16x8 vf = (bf16x8){lo[0], lo[1], lo[2], lo[3], hh[0], hh[1], hh[2], hh[3]};
                    o[dt] = __builtin_amdgcn_mfma_f32_32x32x16_bf16(vf, pa, o[dt], 0, 0, 0); } __builtin_amdgcn_sched_barrier(0); }
#pragma unroll
        for (int dt = 0; dt < 2; ++dt)
#pragma unroll
            for (int rq = 0; rq < 4; ++rq) { u32x2 w; w.x = cvt_pk_bf16(o[dt][4 * rq] * inv, o[dt][4 * rq + 1] * inv); w.y = cvt_pk_bf16(o[dt][4 * rq + 2] * inv, o[dt][4 * rq + 3] * inv);
                *(u32x2*)(qp + 32 * dt + 8 * rq + 4 * hi) = w; }
    }
}

constexpr int RW_BYTES = 11776, RROW = 336, R_WA = 94208, R_WI = 104960, R_CW = 115712, R_XX = 118912;
__device__ __forceinline__ void rnn_unit(LAS unsigned char* lds, bf16_t* proj, const bf16_t* wat, const bf16_t* wit, const Args& A, int unit, int tid, int wid, int lane) {
    asm volatile("" : "+v"(tid), "+v"(lane));
    const int cgp = unit % 5, n = (unit / 5) % 16, b = unit / 80;
    const int co = lane & 31, hi = lane >> 5, chl = cgp * 32 + co, chg = n * 160 + chl;
    LAS unsigned char* Rw = lds + wid * RW_BYTES;
    LAS float* cwl = (LAS float*)(lds + R_CW);
    LAS float* xx = (LAS float*)(lds + R_XX);
    __syncthreads();
    for (int i = tid; i < 800; i += NTHREADS) cwl[i] = (i < 640) ? A.rnn_conv_w[(size_t)(i / 160) * DRNN + n * 160 + (i % 160)] : A.rnn_conv_b[n * 160 + (i - 640)];
    for (int i = tid; i < 2 * 32 * 20; i += NTHREADS) { const int which = i / 640, e = i % 640, o = e / 20, c = e % 20;
        const u32x4 v = *(const u32x4*)((which ? wit : wat) + ((size_t)(n * 160 + cgp * 32 + o)) * 160 + c * 8);
        *(LAS u32x4*)(lds + (which ? R_WI : R_WA) + o * RROW + c * 16) = v; }
    const float cba = A.lru_ba[chg], cbi = A.lru_bi[chg];
    const float lam = A.lru_lambda[chg];
    const float c2 = -8.0f * LOG2E * (fmaxf(-lam, 0.f) + log1pf(expf(-fabsf(lam))));
    __syncthreads();
    float C = 0.f;
    const int cc = (lane < 60) ? (lane % 20) : 0, tp = (lane < 60) ? (lane / 20) : 3;
    for (int ss = 0; ss < 8; ++ss) {
        const int T0 = ss * 256 + wid * 32; const size_t grow0 = (size_t)b * SEQ + T0;
        unsigned ryo = (unsigned)(((unsigned)grow0 + 4u * hi) * PP + C_RY + chg) * 2u; asm volatile("" : "+v"(ryo));
        unsigned short ryv[16];
#pragma unroll
        for (int r = 0; r < 16; ++r) ryv[r] = *(const unsigned short*)((const char*)proj + (ryo + (unsigned)(((r & 3) + 8 * (r >> 2)) * PP * 2)));
#pragma unroll
        for (int i = 0; i < 11; ++i) { const int idx = lane + 64 * i; if (idx < 700) { const int row = idx / 20, c = idx % 20, T = T0 - 3 + row;
                u32x4 v = (u32x4){0u, 0u, 0u, 0u}; if (T >= 0) v = *(const u32x4*)((const char*)proj + (unsigned)(((unsigned)(b * SEQ + T)) * PP + C_RX + n * 160 + c * 8) * 2u);
                *(LAS u32x4*)(Rw + row * RROW + c * 16) = v; } }
        {
            f32x4 wk[4][2], bbv[2];
#pragma unroll
            for (int k = 0; k < 4; ++k) { wk[k][0] = *(const LAS f32x4*)(cwl + k * 160 + 8 * cc); wk[k][1] = *(const LAS f32x4*)(cwl + k * 160 + 8 * cc + 4); }
            bbv[0] = *(const LAS f32x4*)(cwl + 640 + 8 * cc); bbv[1] = *(const LAS f32x4*)(cwl + 640 + 8 * cc + 4);
            u32x4 outs[11];
#pragma unroll
            for (int i = 0; i < 11; ++i) { const int t = tp + 3 * i; f32x4 a0 = bbv[0], a1 = bbv[1];
                if (t < 32 && tp < 3) {
#pragma unroll
                    for (int k = 0; k < 4; ++k) { const u32x4 rv = *(const LAS u32x4*)(Rw + (t + k) * RROW + cc * 16);
                        a0[0] += wk[k][0][0] * bflo(rv.x); a0[1] += wk[k][0][1] * bfhi(rv.x); a0[2] += wk[k][0][2] * bflo(rv.y); a0[3] += wk[k][0][3] * bfhi(rv.y);
                        a1[0] += wk[k][1][0] * bflo(rv.z); a1[1] += wk[k][1][1] * bfhi(rv.z); a1[2] += wk[k][1][2] * bflo(rv.w); a1[3] += wk[k][1][3] * bfhi(rv.w); } }
                outs[i].x = cvt_pk_bf16(a0[0], a0[1]); outs[i].y = cvt_pk_bf16(a0[2], a0[3]); outs[i].z = cvt_pk_bf16(a1[0], a1[1]); outs[i].w = cvt_pk_bf16(a1[2], a1[3]); }
            asm volatile("s_waitcnt lgkmcnt(0)" ::: "memory");
#pragma unroll
            for (int i = 0; i < 11; ++i) { const int t = tp + 3 * i; if (t < 32 && tp < 3) *(LAS u32x4*)(Rw + (t + 3) * RROW + cc * 16) = outs[i]; }
        }
        f32x16 ga, gi;
#pragma unroll
        for (int r = 0; r < 16; ++r) { ga[r] = 0.f; gi[r] = 0.f; }
#pragma unroll
        for (int ks = 0; ks < 10; ++ks) { const bf16x8 xa = *(const LAS bf16x8*)(Rw + (co + 3) * RROW + (16 * ks + 8 * hi) * 2);
            const bf16x8 wa = *(const LAS bf16x8*)(lds + R_WA + co * RROW + (16 * ks + 8 * hi) * 2), wi = *(const LAS bf16x8*)(lds + R_WI + co * RROW + (16 * ks + 8 * hi) * 2);
            ga = __builtin_amdgcn_mfma_f32_32x32x16_bf16(xa, wa, ga, 0, 0, 0); gi = __builtin_amdgcn_mfma_f32_32x32x16_bf16(xa, wi, gi, 0, 0, 0); }
        float hl[16], ca[16], Ae[4], He[4];
#pragma unroll
        for (int rq = 0; rq < 4; ++rq) { float hacc = 0.f, aacc = 1.f;
#pragma unroll
            for (int j = 0; j < 4; ++j) { const int r = 4 * rq + j;
                const float xcv = bf2f(*(const LAS unsigned short*)(Rw + (crow(r, hi) + 3) * RROW + chl * 2));
                const float rr = sigmoidf_(ga[r] + cba), ii = sigmoidf_(gi[r] + cbi);
                const float av = fast_exp2(c2 * rr);
                const float uu = sqrtf(fmaxf(1.0f - av * av, 0.f)) * (ii * xcv);
                hacc = av * hacc + uu; aacc *= av; hl[r] = hacc; ca[r] = aacc; }
            Ae[rq] = aacc; He[rq] = hacc; }
        float cin[4], ast[4]; float cc_ = 0.f, aa_ = 1.f;
#pragma unroll
        for (int rq = 0; rq < 4; ++rq) { const float pA = __shfl_xor(Ae[rq], 32), pH = __shfl_xor(He[rq], 32);
            const float A0 = hi ? pA : Ae[rq], H0 = hi ? pH : He[rq], A1 = hi ? Ae[rq] : pA, H1 = hi ? He[rq] : pH;
            const float c_after0 = A0 * cc_ + H0, a_after0 = aa_ * A0;
            cin[rq] = hi ? c_after0 : cc_; ast[rq] = hi ? a_after0 : aa_;
            cc_ = A1 * c_after0 + H1; aa_ = a_after0 * A1; }
        LAS float* xs = xx + (ss & 1) * 512;
        if (hi == 0) { xs[(wid * 32 + co) * 2] = aa_; xs[(wid * 32 + co) * 2 + 1] = cc_; }
        __syncthreads();
        float cw_in = C, crun = C;
#pragma unroll
        for (int v = 0; v < 8; ++v) { const float av = xs[(v * 32 + co) * 2], hv = xs[(v * 32 + co) * 2 + 1]; if (v == wid) cw_in = crun; crun = av * crun + hv; }
        C = crun;
#pragma unroll
        for (int r = 0; r < 16; ++r) { const int rq = r >> 2;
            const float h0 = hl[r] + ca[r] * cin[rq];
            const float hh = h0 + (ca[r] * ast[rq]) * cw_in;
            const float y = hh * gelu_tanh(bf2f(ryv[r]));
            *(unsigned short*)((char*)proj + (ryo + (unsigned)(((r & 3) + 8 * (r >> 2)) * PP * 2))) = (unsigned short)(cvt_pk_bf16(y, 0.f) & 0xffffu); }
    }
}

__device__ __forceinline__ void ln_rows(float* h, bf16_t* hb, const float* gam, const float* bet, int gw, int NGW, int lane) {
    for (int row = gw; row < M; row += NGW) {
        f32x4* p = (f32x4*)(h + (size_t)row * DM) + lane;
        f32x4 v[8]; float s = 0.f;
#pragma unroll
        for (int j = 0; j < 8; ++j) { v[j] = p[64 * j]; s += (v[j][0] + v[j][1]) + (v[j][2] + v[j][3]); }
#pragma unroll
        for (int o = 1; o < 64; o <<= 1) s += __shfl_xor(s, o);
        const float mean = s * (1.0f / DM); float s2 = 0.f;
#pragma unroll
        for (int j = 0; j < 8; ++j) { v[j] = v[j] - mean; s2 += (v[j][0] * v[j][0] + v[j][1] * v[j][1]) + (v[j][2] * v[j][2] + v[j][3] * v[j][3]); }
#pragma unroll
        for (int o = 1; o < 64; o <<= 1) s2 += __shfl_xor(s2, o);
        const float rstd = 1.0f / sqrtf(s2 * (1.0f / DM) + LN_EPS);
#pragma unroll
        for (int j = 0; j < 8; ++j) { const f32x4 gg = *((const f32x4*)gam + lane + 64 * j), bb = *((const f32x4*)bet + lane + 64 * j);
            const f32x4 y = v[j] * rstd * gg + bb; p[64 * j] = y;
            if (hb) { u32x2 w; w.x = cvt_pk_bf16(y[0], y[1]); w.y = cvt_pk_bf16(y[2], y[3]); *((u32x2*)(hb + (size_t)row * DM) + lane + 64 * j) = w; } }
    }
}

__global__ void __launch_bounds__(NTHREADS, 2) fwd_kernel(Args a) {
    extern __shared__ __attribute__((aligned(16))) unsigned char lds_raw[];
    LAS unsigned char* lds = (LAS unsigned char*)lds_raw;
    cg::grid_group grid = cg::this_grid();
    const int tid = threadIdx.x, lane = tid & 63, wid = __builtin_amdgcn_readfirstlane(tid >> 6);
    const int G = gridDim.x, bx = blockIdx.x;
    const int gw = bx * NWAVES + wid, NGW = G * NWAVES, gtid = bx * NTHREADS + tid, NGT = G * NTHREADS;
    unsigned char* ws = a.ws;
    bf16_t* wat = (bf16_t*)(ws + WS_LRU); bf16_t* wit = wat + 16 * 160 * 160;
    bf16_t* win = (bf16_t*)(ws + WS_WIN); bf16_t* wcat = (bf16_t*)(ws + WS_WCAT); bf16_t* wout = (bf16_t*)(ws + WS_WOUT); bf16_t* wug = (bf16_t*)(ws + WS_WUG); bf16_t* wdn = (bf16_t*)(ws + WS_WDN);
    bf16_t* xb = (bf16_t*)(ws + WS_XB); bf16_t* proj = (bf16_t*)(ws + WS_PROJ); bf16_t* act = proj;
    bf16_t* gate = (bf16_t*)a.out;
    float* gtail = (float*)(ws + WS_STASH); float* ghead = gtail + 64 * 2 * DFF; float* uhead = ghead + 64 * 2 * DFF;
    const int lo = a.ph_lo, hi = a.ph_hi;
#ifndef PH2_MASK
#define PH2_MASK 3
#endif
#ifndef PH_MASK
#define PH_MASK 0x3ff
#endif
#define IN(k) (((PH_MASK >> (k)) & 1) && lo <= (k) && (k) < hi)
#define SEAM(k) do { if (IN(k) && IN((k) + 1)) grid.sync(); } while (0)

    if (IN(0)) prologue(a, lds, gw, NGW, wid, lane, gtid, NGT);
    SEAM(0);
    if (IN(1)) { pg8::Gemm g{xb, win, DM, DM, DM}; pg8::StaticOrder S; S.init(M, DIN, G, bx); pg8::EpiProj E{proj, gate, a.b_gate}; pg8::gemm_phase(lds, g, S, E); }
    SEAM(1);
    if (IN(2)) {
        for (int it = bx; it < 640 + 512; it += G) { if (it < 640) { if (PH2_MASK & 1) rnn_unit(lds, proj, wat, wit, a, it, tid, wid, lane); } else { if (PH2_MASK & 2) attn_unit(lds, proj, a.attn_sinks, it - 640, tid, wid, lane); } }
    }
    SEAM(2);
    if (IN(3)) { pg8::Gemm g{proj, wcat, PP, KCAT, KCAT}; pg8::StaticOrder S; S.init(M, DM, G, bx); pg8::EpiMerge E{gate, xb, 32}; pg8::gemm_phase(lds, g, S, E); }
    SEAM(3);
    if (IN(4)) { pg8::Gemm g{xb, wout, DM, DM, DM}; pg8::StaticOrder S; S.init(M, DM, G, bx); pg8::EpiRes E{a.x, a.out}; pg8::gemm_phase(lds, g, S, E); }
    SEAM(4);
    if (IN(5)) ln_rows(a.out, xb, a.ln1_g, a.ln1_b, gw, NGW, lane);
    SEAM(5);
    if (IN(6)) { pg8::Gemm g{xb, wug, DM, DM, DM}; pg8::StaticOrder S; S.init(M, 2 * DFF, G, bx); pg8::EpiGlu E{act, a.ffn_conv_w, a.ffn_conv_b, gtail, ghead, uhead}; pg8::gemm_phase(lds, g, S, E); }
    SEAM(6);
    if (IN(7)) {
        for (int i = gtid; i < 64 * 2 * DFF; i += NGT) { const int pm = i / (2 * DFF), rr = (i / DFF) & 1, ch = i % DFF;
            if ((pm & 7) == 0) continue;
            const float t0 = gtail[((size_t)(pm - 1) * 2 + 0) * DFF + ch], t1 = gtail[((size_t)(pm - 1) * 2 + 1) * DFF + ch], h0 = ghead[((size_t)pm * 2 + 0) * DFF + ch], h1 = ghead[((size_t)pm * 2 + 1) * DFF + ch];
            const float w0 = a.ffn_conv_w[ch], w1 = a.ffn_conv_w[DFF + ch], w2 = a.ffn_conv_w[2 * DFF + ch], bb = a.ffn_conv_b[ch];
            const float cv = rr ? (w0 * t1 + w1 * h0 + w2 * h1 + bb) : (w0 * t0 + w1 * t1 + w2 * h0 + bb);
            const float y = gelu_tanh(cv) * uhead[((size_t)pm * 2 + rr) * DFF + ch];
            act[(size_t)(pm * 256 + rr) * DFF + ch] = (bf16_t)(cvt_pk_bf16(y, 0.f) & 0xffffu); }
    }
    SEAM(7);
    if (IN(8)) { pg8::Gemm g{act, wdn, DFF, DFF, DFF}; pg8::StaticOrder S; S.init(M, DM, G, bx); pg8::EpiRes E{a.out, a.out}; pg8::gemm_phase(lds, g, S, E); }
    SEAM(8);
    if (IN(9)) ln_rows(a.out, nullptr, a.ln2_g, a.ln2_b, gw, NGW, lane);
#undef IN
#undef SEAM
}

#ifndef MK_PER_PHASE
#define MK_PER_PHASE 0
#endif
extern "C" void kernel_launch(void* const* d_in, const int* in_sizes, int n_in, void* d_out, int out_size, void* d_ws, size_t ws_size, hipStream_t stream) {
    static int grid = 0;
    if (grid == 0) {
        if (n_in != 23 || out_size != M * DM || ws_size < WS_END) { fprintf(stderr, "kernel_launch: unexpected problem: n_in %d out %d ws %zu\n", n_in, out_size, ws_size); grid = -1; return; }
        int dev = 0, cus = 0, per_cu = 0;
        hipGetDevice(&dev); hipDeviceGetAttribute(&cus, hipDeviceAttributeMultiprocessorCount, dev);
        hipFuncSetAttribute((const void*)fwd_kernel, hipFuncAttributeMaxDynamicSharedMemorySize, LDS_BYTES);
        hipOccupancyMaxActiveBlocksPerMultiprocessor(&per_cu, (const void*)fwd_kernel, NTHREADS, LDS_BYTES);
        if (per_cu < 1) { fprintf(stderr, "kernel_launch: occupancy query says %d blocks/CU\n", per_cu); per_cu = 1; }
        (void)hipGetLastError();
        grid = cus;
    }
    if (grid < 0) return;
    Args a{};
    const float** f = (const float**)&a;
    for (int i = 0; i < 23; ++i) f[i] = (const float*)d_in[i];
    a.out = (float*)d_out; a.ws = (unsigned char*)d_ws;
#if MK_PER_PHASE
    for (int p = 0; p < 10; ++p) { a.ph_lo = p; a.ph_hi = p + 1; hipLaunchKernelGGL(fwd_kernel, dim3(grid), dim3(NTHREADS), LDS_BYTES, stream, a); }
#else
    a.ph_lo = 0; a.ph_hi = 10;
    void* args[] = {&a};
    hipError_t e = hipLaunchCooperativeKernel((const void*)fwd_kernel, dim3(grid), dim3(NTHREADS), args, LDS_BYTES, stream);
    if (e != hipSuccess) fprintf(stderr, "cooperative launch failed: %s (grid %d)\n", hipGetErrorString(e), grid);
#endif
}
```

```cpp
#include <hip/hip_runtime.h>
#include <hip/hip_cooperative_groups.h>
#include <cstdio>
#include <cstdint>
namespace cg = cooperative_groups;

#define LAS __attribute__((address_space(3)))
typedef unsigned short bf16_t;
typedef short bf16x8 __attribute__((ext_vector_type(8)));
typedef short s16x4 __attribute__((ext_vector_type(4)));
typedef float f32x4 __attribute__((ext_vector_type(4)));
typedef float f32x16 __attribute__((ext_vector_type(16)));
typedef unsigned u32x4 __attribute__((ext_vector_type(4)));
typedef unsigned u32x2 __attribute__((ext_vector_type(2)));

constexpr int M = 16384, DM = 2048, SEQ = 2048;
constexpr int DIN = 11776, PP = 7680  , GP = 4096  ;
constexpr int C_Q = 0, C_RY = 2048, C_K = 4608, C_V = 4864, C_RX = 5120;
constexpr int DRNN = 2560, DFF = 6144, KCAT = 4608;
constexpr float ALPHA = 1.189207115002721f;
constexpr float LN_EPS = 1e-5f;
constexpr float LOG2E = 1.4426950408889634f;

constexpr size_t MiB = 1u << 20;
constexpr size_t WS_LRU = 1 * MiB, WS_STASH = 3 * MiB, WS_WIN = 12 * MiB, WS_WCAT = 58 * MiB, WS_WOUT = 76 * MiB, WS_WUG = 84 * MiB, WS_WDN = 132 * MiB,
                 WS_XB = 156 * MiB, WS_PROJ = 220 * MiB, WS_END = 460 * MiB;
constexpr int NWAVES = 8, NTHREADS = 512;
constexpr int LDS_BYTES = 147456, XLDS_OFF = 131072;

__device__ __forceinline__ unsigned cvt_pk_bf16(float lo, float hi) { unsigned r; asm volatile("v_cvt_pk_bf16_f32 %0, %1, %2" : "=v"(r) : "v"(lo), "v"(hi)); return r; }
__device__ __forceinline__ float bf2f(unsigned short h) { return __uint_as_float(((unsigned)h) << 16); }
__device__ __forceinline__ float bflo(unsigned w) { return __uint_as_float(w << 16); }
__device__ __forceinline__ float bfhi(unsigned w) { return __uint_as_float(w & 0xffff0000u); }
__device__ __forceinline__ float fast_exp2(float x) { return __builtin_amdgcn_exp2f(x); }
__device__ __forceinline__ float fast_rcp(float x) { return __builtin_amdgcn_rcpf(x); }
__device__ __forceinline__ float sigmoidf_(float z) { return fast_rcp(1.0f + fast_exp2(-LOG2E * z)); }
__device__ __forceinline__ float gelu_tanh(float x) {
    const float u = x * (0.7978845608028654f + 0.035677408136300125f * x * x);
    return x * fast_rcp(1.0f + fast_exp2(-2.0f * LOG2E * u));
}
__device__ __forceinline__ int crow(int r, int hi) { return (r & 3) + 8 * (r >> 2) + 4 * hi; }
__device__ __forceinline__ float lane_from(float v, int src) { return __int_as_float(__builtin_amdgcn_ds_bpermute(src << 2, __float_as_int(v))); }

namespace pg8 {
constexpr int BM = 256, BK = 64, HALF = 128, HTB = HALF * BK * 2, STAGE_BYTES = 8 * HTB, NXCD = 8, WGM = 8;
__host__ __device__ __forceinline__ int lds_byte(int r, int c) { const int st = (r >> 4) * 2 + (c >> 5), rr = r & 15, cc = c & 31, ob = rr * 64 + cc * 2; return st * 1024 + (ob ^ (((ob >> 9) & 1) << 5)); }
__host__ __device__ __forceinline__ void stage_rc(int b, int& R, int& C) { const int st = b / 1024, sb = b % 1024, swz = sb ^ (((sb >> 9) & 1) << 5); R = (st >> 1) * 16 + swz / 64; C = (st & 1) * 32 + (swz % 64) / 2; }
__host__ __device__ __forceinline__ int perm32(int rho) { const int n = rho >> 4, i = rho & 15; return 8 * (i >> 2) + 4 * n + (i & 3); }

struct Unit { int pm, pn; };
struct Gemm { const bf16_t* A; const bf16_t* Bt; int lda, ldb, K; };

struct StaticOrder {
    int nM, nN, nwg, G, c;
    __device__ void init(int M_, int N_, int G_, int c_) { nM = M_ / BM; nN = N_ / BM; nwg = nM * nN; G = G_; c = c_; }
    __device__ bool next(int i, Unit& u) const {
        const long L = (long)i * G + c; if (L >= nwg) return false;
        int wgid = (int)L; { const int q = nwg / NXCD, r = nwg % NXCD, xcd = wgid % NXCD, off = wgid / NXCD; wgid = (xcd < r ? xcd * (q + 1) : r * (q + 1) + (xcd - r) * q) + off; }
        const int nig = WGM * nN, gid = wgid / nig, fm = gid * WGM, gsz = (nM - fm) < WGM ? (nM - fm) : WGM;
        u.pm = fm + ((wgid % nig) % gsz); u.pn = (wgid % nig) / gsz; return true;
    }
};

typedef f32x4 Acc[2][2][4][2];

struct EpiProj {
    static constexpr bool PERM = true, HAS_MID = false;
    bf16_t* proj; bf16_t* gate; const float* bgate;
    __device__ __forceinline__ void mid(Acc&, const Unit&, int, int, int, int) const {}
    __device__ __forceinline__ void operator()(Acc& acc, const Unit& u, int wr, int wc, int fr, int fq, LAS unsigned char*, int) const {
        const int row0 = u.pm * BM + wr * 64 + fr;
        const bool isg = u.pn >= 30;
        bf16_t* base = isg ? gate : proj; const int ldc = isg ? GP : PP;
        const int col0 = (isg ? (u.pn - 30) : u.pn) * BM + wc * 32 + 8 * fq;
        f32x4 bv[2][2];
#pragma unroll
        for (int bj = 0; bj < 2; ++bj)
#pragma unroll
            for (int n = 0; n < 2; ++n) bv[bj][n] = isg ? *(const f32x4*)(bgate + col0 + bj * HALF + 4 * n) : (f32x4){0.f, 0.f, 0.f, 0.f};
#pragma unroll
        for (int ai = 0; ai < 2; ++ai)
#pragma unroll
            for (int m = 0; m < 4; ++m) { bf16_t* rowp = base + (size_t)(row0 + ai * HALF + m * 16) * ldc + col0;
#pragma unroll
                for (int bj = 0; bj < 2; ++bj) { f32x4 v0 = acc[ai][bj][m][0] + bv[bj][0], v1 = acc[ai][bj][m][1] + bv[bj][1];
                    if (isg) {
#pragma unroll
                        for (int j = 0; j < 4; ++j) { v0[j] = sigmoidf_(v0[j]); v1[j] = sigmoidf_(v1[j]); } }
                    u32x4 w; w.x = cvt_pk_bf16(v0[0], v0[1]); w.y = cvt_pk_bf16(v0[2], v0[3]); w.z = cvt_pk_bf16(v1[0], v1[1]); w.w = cvt_pk_bf16(v1[2], v1[3]);
                    *(u32x4*)(rowp + bj * HALF) = w; } }
    }
};

struct EpiMerge {
    static constexpr bool PERM = true, HAS_MID = true;
    const bf16_t* gate; bf16_t* out; int mid_t;
    __device__ __forceinline__ void mid(Acc& acc, const Unit& u, int wr, int wc, int fr, int fq) const {
        const int row0 = u.pm * BM + wr * 64 + fr, col0 = u.pn * BM + wc * 32 + 8 * fq;
#pragma unroll
        for (int ai = 0; ai < 2; ++ai)
#pragma unroll
            for (int m = 0; m < 4; ++m) { unsigned go = (unsigned)((row0 + ai * HALF + m * 16) * GP + col0) * 2u; asm volatile("" : "+v"(go)); const char* gp = (const char*)gate + go;
#pragma unroll
                for (int bj = 0; bj < 2; ++bj) { const u32x4 a = *(const u32x4*)(gp + bj * HALF * 2), r = *(const u32x4*)(gp + (2048 + bj * HALF) * 2);
                    f32x4 q0, q1;
                    q0[0] = bflo(a.x) * fast_rcp(bflo(r.x)); q0[1] = bfhi(a.x) * fast_rcp(bfhi(r.x)); q0[2] = bflo(a.y) * fast_rcp(bflo(r.y)); q0[3] = bfhi(a.y) * fast_rcp(bfhi(r.y));
                    q1[0] = bflo(a.z) * fast_rcp(bflo(r.z)); q1[1] = bfhi(a.z) * fast_rcp(bfhi(r.z)); q1[2] = bflo(a.w) * fast_rcp(bflo(r.w)); q1[3] = bfhi(a.w) * fast_rcp(bfhi(r.w));
                    acc[ai][bj][m][0] *= q0; acc[ai][bj][m][1] *= q1; asm volatile("" ::: "memory"); __builtin_amdgcn_sched_barrier(0); } }
    }
    __device__ __forceinline__ void operator()(Acc& acc, const Unit& u, int wr, int wc, int fr, int fq, LAS unsigned char*, int) const {
        const int row0 = u.pm * BM + wr * 64 + fr, col0 = u.pn * BM + wc * 32 + 8 * fq;
#pragma unroll
        for (int ai = 0; ai < 2; ++ai)
#pragma unroll
            for (int m = 0; m < 4; ++m) { const unsigned ro = (unsigned)(row0 + ai * HALF + m * 16);
#pragma unroll
                for (int bj = 0; bj < 2; ++bj) { const u32x4 r = *(const u32x4*)((const char*)gate + (ro * GP + 2048 + col0 + bj * HALF) * 2u);
                    const f32x4 v0 = acc[ai][bj][m][0], v1 = acc[ai][bj][m][1];
                    u32x4 w; w.x = cvt_pk_bf16(v0[0] * bflo(r.x), v0[1] * bfhi(r.x)); w.y = cvt_pk_bf16(v0[2] * bflo(r.y), v0[3] * bfhi(r.y));
                    w.z = cvt_pk_bf16(v1[0] * bflo(r.z), v1[1] * bfhi(r.z)); w.w = cvt_pk_bf16(v1[2] * bflo(r.w), v1[3] * bfhi(r.w));
                    *(u32x4*)((char*)out + (ro * DM + col0 + bj * HALF) * 2u) = w; }
                asm volatile("" ::: "memory"); }
    }
};

struct EpiRes {
    static constexpr bool PERM = false, HAS_MID = false;
    const float* base; float* out;
    __device__ __forceinline__ void mid(Acc&, const Unit&, int, int, int, int) const {}
    __device__ __forceinline__ void operator()(Acc& acc, const Unit& u, int wr, int wc, int fr, int fq, LAS unsigned char*, int) const {
        const int col0 = u.pn * BM + wc * 32 + 4 * fq;
#pragma unroll
        for (int ai = 0; ai < 2; ++ai)
#pragma unroll
            for (int m = 0; m < 4; ++m) { const size_t off = (size_t)(u.pm * BM + ai * HALF + wr * 64 + m * 16 + fr) * DM + col0;
#pragma unroll
                for (int bj = 0; bj < 2; ++bj)
#pragma unroll
                    for (int n = 0; n < 2; ++n) { const f32x4 bs = *(const f32x4*)(base + off + bj * HALF + n * 16); *(f32x4*)(out + off + bj * HALF + n * 16) = bs * ALPHA + acc[ai][bj][m][n]; }
                if (m & 1) asm volatile("" ::: "memory"); }
    }
};

struct EpiGlu {
    static constexpr bool PERM = true, HAS_MID = false;
    bf16_t* act; const float* cw; const float* cb; float* gtail; float* ghead; float* uhead;
    __device__ __forceinline__ void mid(Acc&, const Unit&, int, int, int, int) const {}
    __device__ __forceinline__ void operator()(Acc& acc, const Unit& u, int wr, int wc, int fr, int fq, LAS unsigned char* xl, int lane) const {
        const int chl = wc * 32 + 8 * fq, ch0 = u.pn * 128 + chl;
        if (fr >= 14) {
#pragma unroll
            for (int ai = 0; ai < 2; ++ai)
#pragma unroll
                for (int n = 0; n < 2; ++n) *(LAS f32x4*)(xl + (((ai * 2 + wr) * 2 + (fr - 14)) * 128 + chl + 4 * n) * 4) = acc[ai][1][3][n];
            if (wr == 1) {
#pragma unroll
                for (int n = 0; n < 2; ++n) *(f32x4*)(gtail + ((size_t)(u.pm * 2 + (fr - 14))) * DFF + ch0 + 4 * n) = acc[1][1][3][n]; }
        }
        if (fr < 2 && wr == 0) {
#pragma unroll
            for (int n = 0; n < 2; ++n) { *(f32x4*)(ghead + ((size_t)(u.pm * 2 + fr)) * DFF + ch0 + 4 * n) = acc[0][1][0][n]; *(f32x4*)(uhead + ((size_t)(u.pm * 2 + fr)) * DFF + ch0 + 4 * n) = acc[0][0][0][n]; }
        }
        f32x4 w0[2], w1[2], w2[2], bb[2];
#pragma unroll
        for (int n = 0; n < 2; ++n) { w0[n] = *(const f32x4*)(cw + ch0 + 4 * n); w1[n] = *(const f32x4*)(cw + DFF + ch0 + 4 * n); w2[n] = *(const f32x4*)(cw + 2 * DFF + ch0 + 4 * n); bb[n] = *(const f32x4*)(cb + ch0 + 4 * n); }
        asm volatile("s_waitcnt lgkmcnt(0)" ::: "memory"); __builtin_amdgcn_s_barrier(); asm volatile("" ::: "memory");
        const int l1 = lane - 1, l2 = lane - 2, l15 = lane + 15, l14 = lane + 14;
#pragma unroll
        for (int ai = 0; ai < 2; ++ai) {
            f32x4 h62[2], h63[2];
            const bool hz = (wr == 0 && ai == 0); const int hb = (wr == 1) ? (ai * 2) : ((ai - 1) * 2 + 1);
#pragma unroll
            for (int n = 0; n < 2; ++n) { if (hz) { h62[n] = (f32x4){0.f, 0.f, 0.f, 0.f}; h63[n] = h62[n]; } else { h62[n] = *(const LAS f32x4*)(xl + ((hb * 2 + 0) * 128 + chl + 4 * n) * 4); h63[n] = *(const LAS f32x4*)(xl + ((hb * 2 + 1) * 128 + chl + 4 * n) * 4); } }
#pragma unroll
            for (int m = 0; m < 4; ++m) { u32x4 w; float o[8];
#pragma unroll
                for (int n = 0; n < 2; ++n)
#pragma unroll
                    for (int j = 0; j < 4; ++j) { const float g = acc[ai][1][m][n][j];
                        float a1 = lane_from(g, l1), a2 = lane_from(g, l2), b1, b2;
                        if (m == 0) { b1 = h63[n][j]; b2 = (fr == 0) ? h62[n][j] : h63[n][j]; }
                        else { const float gp = acc[ai][1][m - 1][n][j]; b1 = lane_from(gp, l15); b2 = lane_from(gp, l14); }
                        const float p1 = (fr >= 1) ? a1 : b1, p2 = (fr >= 2) ? a2 : b2;
                        const float cv = w0[n][j] * p2 + w1[n][j] * p1 + w2[n][j] * g + bb[n][j];
                        o[n * 4 + j] = gelu_tanh(cv) * acc[ai][0][m][n][j]; }
                w.x = cvt_pk_bf16(o[0], o[1]); w.y = cvt_pk_bf16(o[2], o[3]); w.z = cvt_pk_bf16(o[4], o[5]); w.w = cvt_pk_bf16(o[6], o[7]);
                *(u32x4*)(act + (size_t)(u.pm * BM + ai * HALF + wr * 64 + m * 16 + fr) * DFF + ch0) = w; }
        }
    }
};

template <class Epi>
__device__ __forceinline__ void gemm_phase(LAS unsigned char* lds, const Gemm g, const StaticOrder& S, const Epi& E) {
    const int tid = threadIdx.x, wid = __builtin_amdgcn_readfirstlane(tid >> 6), lane = tid & 63, wr = wid >> 2, wc = wid & 3, fr = lane & 15, fq = lane >> 4;
    const int K = g.K, nt = K / BK;
    unsigned voffA[2], voffB[2];
#pragma unroll
    for (int i = 0; i < 2; ++i) { int R, C; stage_rc(tid * 16 + i * 8192, R, C); const int Rb = Epi::PERM ? ((R & ~31) + perm32(R & 31)) : R;
        voffA[i] = (unsigned)(R * g.lda + C) * 2u; voffB[i] = (unsigned)(Rb * g.ldb + C) * 2u; }
    const size_t kstep = (size_t)(BK * 2);
    const size_t hstepA = (size_t)HALF * g.lda * 2, hstepB = (size_t)HALF * g.ldb * 2;
    const size_t tstepA = 2 * hstepA, tstepB = 2 * hstepB;
    const unsigned ldsw = (unsigned)wid * 1024u;
    const int aoff = lds_byte(wr * 64 + fr, fq * 8), boff = lds_byte(wc * 32 + fr, fq * 8);
#define PG8_SA(b, h) (((b) * 2 + (h)) * HTB)
#define PG8_SB(b, h) ((4 + (b) * 2 + (h)) * HTB)
#define PG8_STAGE(bufoff, gbase, voff) do { _Pragma("unroll") for (int _i = 0; _i < 2; ++_i) \
        __builtin_amdgcn_global_load_lds((const unsigned*)((const char*)(gbase) + (voff)[_i]), (LAS unsigned*)(lds + (bufoff) + ldsw + _i * 8192), 16, 0, 0); } while (0)
#define PG8_LDA(dst, b, h) do { _Pragma("unroll") for (int m = 0; m < 4; ++m) _Pragma("unroll") for (int k = 0; k < 2; ++k) dst[m][k] = *(const LAS bf16x8*)(lds + PG8_SA(b, h) + aoff + m * 2048 + k * 1024); } while (0)
#define PG8_LDB(dst, b, h) do { _Pragma("unroll") for (int n = 0; n < 2; ++n) _Pragma("unroll") for (int k = 0; k < 2; ++k) dst[n][k] = *(const LAS bf16x8*)(lds + PG8_SB(b, h) + boff + n * 2048 + k * 1024); } while (0)
#define PG8_MMA(ai, bj, At, Bt) do { __builtin_amdgcn_s_setprio(1); _Pragma("unroll") for (int m = 0; m < 4; ++m) _Pragma("unroll") for (int n = 0; n < 2; ++n) _Pragma("unroll") for (int k = 0; k < 2; ++k) \
        acc[ai][bj][m][n] = __builtin_amdgcn_mfma_f32_16x16x32_bf16(Bt[n][k], At[m][k], acc[ai][bj][m][n], 0, 0, 0); __builtin_amdgcn_s_setprio(0); } while (0)
#define PG8_WAIT_V(n) asm volatile("s_waitcnt vmcnt(" #n ")" ::: "memory")
#define PG8_WAIT_L(n) asm volatile("s_waitcnt lgkmcnt(" #n ")" ::: "memory")
#define PG8_BAR __builtin_amdgcn_s_barrier()
#define PG8_SCHED __builtin_amdgcn_sched_barrier(0)
    Unit cur, nxt; int ui = 0;
    if (!S.next(0, cur)) return;
    Acc acc;
#pragma unroll
    for (int a = 0; a < 2; ++a)
#pragma unroll
        for (int b = 0; b < 2; ++b)
#pragma unroll
            for (int m = 0; m < 4; ++m)
#pragma unroll
                for (int n = 0; n < 2; ++n) acc[a][b][m][n] = (f32x4){0.f, 0.f, 0.f, 0.f};
    bf16x8 At[4][2], B0[2][2], B1[2][2];
    const char* cA = (const char*)g.A + (size_t)cur.pm * tstepA; const char* cB = (const char*)g.Bt + (size_t)cur.pn * tstepB;
    PG8_STAGE(PG8_SB(0, 0), cB, voffB); PG8_STAGE(PG8_SB(0, 1), cB + hstepB, voffB); PG8_STAGE(PG8_SA(0, 0), cA, voffA); PG8_STAGE(PG8_SA(0, 1), cA + hstepA, voffA);
    if (wr == 1) PG8_BAR;
    PG8_WAIT_V(2); PG8_BAR;
    PG8_STAGE(PG8_SB(1, 0), cB + kstep, voffB); PG8_STAGE(PG8_SA(1, 0), cA + kstep, voffA); PG8_STAGE(PG8_SB(1, 1), cB + hstepB + kstep, voffB);
    PG8_WAIT_V(6); PG8_BAR;
    for (;;) {
        const bool has_next = S.next(ui + 1, nxt);
        const char* nA = has_next ? (const char*)g.A + (size_t)nxt.pm * tstepA : cA; const char* nB = has_next ? (const char*)g.Bt + (size_t)nxt.pn * tstepB : cB;
        for (int t = 0; t < nt; t += 2) {
            const bool last = (t == nt - 2);
            const char* a1 = cA + (size_t)(t + 1) * kstep;
            const char* a2 = last ? nA : cA + (size_t)(t + 2) * kstep; const char* b2 = last ? nB : cB + (size_t)(t + 2) * kstep;
            const char* a3 = a2 + kstep; const char* b3 = b2 + kstep;
            if constexpr (Epi::HAS_MID) { if (t == E.mid_t) { PG8_SCHED; E.mid(acc, cur, wr, wc, fr, fq); PG8_SCHED; } }
            PG8_LDB(B0, 0, 0); PG8_LDB(B1, 0, 1); PG8_SCHED; PG8_LDA(At, 0, 0); PG8_STAGE(PG8_SA(1, 1), a1 + hstepA, voffA);
            PG8_WAIT_V(8); PG8_WAIT_L(0); PG8_BAR; PG8_MMA(0, 0, At, B0); PG8_MMA(0, 1, At, B1); PG8_BAR; PG8_SCHED;
            PG8_LDA(At, 0, 1); PG8_STAGE(PG8_SB(0, 0), b2, voffB); PG8_STAGE(PG8_SB(0, 1), b2 + hstepB, voffB); PG8_STAGE(PG8_SA(0, 0), a2, voffA);
            PG8_WAIT_V(8); PG8_WAIT_L(0); PG8_BAR; PG8_MMA(1, 0, At, B0); PG8_MMA(1, 1, At, B1); PG8_BAR; PG8_SCHED;
            PG8_LDB(B0, 1, 0); PG8_LDB(B1, 1, 1); PG8_SCHED; PG8_LDA(At, 1, 0); PG8_STAGE(PG8_SA(0, 1), a2 + hstepA, voffA);
            PG8_WAIT_V(8); PG8_WAIT_L(0); PG8_BAR; PG8_MMA(0, 0, At, B0); PG8_MMA(0, 1, At, B1); PG8_BAR; PG8_SCHED;
            PG8_LDA(At, 1, 1); PG8_STAGE(PG8_SB(1, 0), b3, voffB); PG8_STAGE(PG8_SB(1, 1), b3 + hstepB, voffB); PG8_STAGE(PG8_SA(1, 0), a3, voffA);
            PG8_WAIT_V(8); PG8_WAIT_L(0); PG8_BAR; PG8_MMA(1, 0, At, B0); PG8_MMA(1, 1, At, B1); PG8_BAR; PG8_SCHED;
        }
        if (wr == 0) PG8_BAR;
        E(acc, cur, wr, wc, fr, fq, lds + XLDS_OFF, lane);
        if (!has_next) break;
#pragma unroll
        for (int a = 0; a < 2; ++a)
#pragma unroll
            for (int b = 0; b < 2; ++b)
#pragma unroll
                for (int m = 0; m < 4; ++m)
#pragma unroll
                    for (int n = 0; n < 2; ++n) acc[a][b][m][n] = (f32x4){0.f, 0.f, 0.f, 0.f};
        cur = nxt; cA = nA; cB = nB; ++ui;
        if (wr == 1) PG8_BAR;
    }
    PG8_WAIT_V(0);
    PG8_BAR;
#undef PG8_SA
#undef PG8_SB
#undef PG8_STAGE
#undef PG8_LDA
#undef PG8_LDB
#undef PG8_MMA
#undef PG8_WAIT_V
#undef PG8_WAIT_L
#undef PG8_BAR
#undef PG8_SCHED
}
}

struct Args {
    const float* x; const float* w_in; const float* b_gate; const float* rnn_conv_w; const float* rnn_conv_b; const float* lru_wa; const float* lru_ba; const float* lru_wi; const float* lru_bi;
    const float* lru_lambda; const float* attn_sinks; const float* w_attn_proj; const float* w_rnn_proj; const float* w_out; const float* ln1_g; const float* ln1_b;
    const float* ffn_w_up; const float* ffn_w_gate; const float* ffn_conv_w; const float* ffn_conv_b; const float* ffn_w_down; const float* ln2_g; const float* ln2_b;
    float* out; unsigned char* ws; int ph_lo, ph_hi;
};

__device__ __forceinline__ void tr_item(const float* W, int N, bf16_t* WT, int ldt, int koff, int drow, LAS float* scr, int k0, int n0, int lane) {
#pragma unroll 8
    for (int i = 0; i < 32; ++i) { const int kk = 2 * i + (lane >> 5); scr[kk * 33 + (lane & 31)] = W[(size_t)(k0 + kk) * N + n0 + (lane & 31)]; }
    asm volatile("s_waitcnt lgkmcnt(0)" ::: "memory");
    const int c = lane & 7;
#pragma unroll
    for (int j = 0; j < 4; ++j) { const int n = (lane >> 3) + 8 * j; const LAS float* s = scr + (8 * c) * 33 + n;
        u32x4 o; o.x = cvt_pk_bf16(s[0 * 33], s[1 * 33]); o.y = cvt_pk_bf16(s[2 * 33], s[3 * 33]); o.z = cvt_pk_bf16(s[4 * 33], s[5 * 33]); o.w = cvt_pk_bf16(s[6 * 33], s[7 * 33]);
        *(u32x4*)(WT + (size_t)(drow + n) * ldt + koff + k0 + 8 * c) = o; }
    asm volatile("s_waitcnt lgkmcnt(0)" ::: "memory");
}
__device__ __forceinline__ int win_row(int n0) {
    if (n0 < 2048) return n0;
    if (n0 < 2304) return C_K + (n0 - 2048);
    if (n0 < 2560) return C_V + (n0 - 2304);
    if (n0 < 5120) return C_RX + (n0 - 2560);
    if (n0 < 7680) return C_RY + (n0 - 5120);
    return n0;
}
__device__ __forceinline__ void prologue(const Args& a, LAS unsigned char* lds, int gw, int NGW, int wid, int lane, int gtid, int NGT) {
    unsigned char* ws = a.ws;
    bf16_t* win = (bf16_t*)(ws + WS_WIN); bf16_t* wcat = (bf16_t*)(ws + WS_WCAT); bf16_t* wout = (bf16_t*)(ws + WS_WOUT); bf16_t* wug = (bf16_t*)(ws + WS_WUG); bf16_t* wdn = (bf16_t*)(ws + WS_WDN);
    LAS float* scr = (LAS float*)(lds + wid * 16384);
    constexpr int I_IN = 32 * 368, I_AP = 32 * 64, I_RP = 40 * 64, I_WO = 32 * 64, I_UP = 32 * 192, I_GT = 32 * 192, I_DN = 96 * 64;
    constexpr int NITEMS = I_IN + I_AP + I_RP + I_WO + I_UP + I_GT + I_DN;
    for (int it = gw; it < NITEMS; it += NGW) {
        int r = it;
        if (r < I_IN) { const int kb = r / 368, nb = r % 368; tr_item(a.w_in, DIN, win, 2048, 0, win_row(nb * 32), scr, kb * 64, nb * 32, lane); continue; } r -= I_IN;
        if (r < I_AP) { const int kb = r / 64, nb = r % 64; tr_item(a.w_attn_proj, 2048, wcat, KCAT, 0, nb * 32, scr, kb * 64, nb * 32, lane); continue; } r -= I_AP;
        if (r < I_RP) { const int kb = r / 64, nb = r % 64; tr_item(a.w_rnn_proj, 2048, wcat, KCAT, 2048, nb * 32, scr, kb * 64, nb * 32, lane); continue; } r -= I_RP;
        if (r < I_WO) { const int kb = r / 64, nb = r % 64; tr_item(a.w_out, 2048, wout, 2048, 0, nb * 32, scr, kb * 64, nb * 32, lane); continue; } r -= I_WO;
        if (r < I_UP) { const int kb = r / 192, nb = r % 192, n0 = nb * 32; tr_item(a.ffn_w_up, DFF, wug, 2048, 0, (n0 >> 7) * 256 + (n0 & 127), scr, kb * 64, n0, lane); continue; } r -= I_UP;
        if (r < I_GT) { const int kb = r / 192, nb = r % 192, n0 = nb * 32; tr_item(a.ffn_w_gate, DFF, wug, 2048, 0, (n0 >> 7) * 256 + 128 + (n0 & 127), scr, kb * 64, n0, lane); continue; } r -= I_GT;
        { const int kb = r / 64, nb = r % 64; tr_item(a.ffn_w_down, 2048, wdn, DFF, 0, nb * 32, scr, kb * 64, nb * 32, lane); }
    }
    bf16_t* xb = (bf16_t*)(ws + WS_XB);
    for (size_t i = (size_t)gtid; i < (size_t)M * DM / 8; i += NGT) { const f32x4 v0 = *(const f32x4*)(a.x + i * 8), v1 = *(const f32x4*)(a.x + i * 8 + 4);
        u32x4 o; o.x = cvt_pk_bf16(v0[0], v0[1]); o.y = cvt_pk_bf16(v0[2], v0[3]); o.z = cvt_pk_bf16(v1[0], v1[1]); o.w = cvt_pk_bf16(v1[2], v1[3]); *(u32x4*)(xb + i * 8) = o; }
    bf16_t* wat = (bf16_t*)(ws + WS_LRU); bf16_t* wit = wat + 16 * 160 * 160;
    for (int i = gtid; i < 2 * 16 * 160 * 160; i += NGT) { const int which = i / (16 * 160 * 160), e = i % (16 * 160 * 160), n = e / 25600, o = (e % 25600) / 160, k = e % 160;
        const float v = (which ? a.lru_wi : a.lru_wa)[(size_t)n * 25600 + k * 160 + o]; (which ? wit : wat)[e] = (bf16_t)(cvt_pk_bf16(v, 0.f) & 0xffffu); }
}

__device__ __forceinline__ void attn_unit(LAS unsigned char* lds, bf16_t* proj, const float* sinks, int unit, int tid, const int wid, int lane) {
    asm volatile("" : "+v"(tid), "+v"(lane));
    const int qb = unit & 15, g = (unit >> 4) & 3, b = unit >> 6;
    const int tok0 = b * SEQ + qb * 128;
    __syncthreads();
#pragma unroll
    for (int i = 0; i < 4; ++i) { const int c = tid + 512 * i, row = c >> 3, ch = c & 7;
        u32x4 kv = (u32x4){0u, 0u, 0u, 0u}, vv = kv;
        if (qb > 0 || row >= 128) { const bf16_t* p = proj + (size_t)(tok0 - 128 + row) * PP + g * 64 + ch * 8; kv = *(const u32x4*)(p + C_K); vv = *(const u32x4*)(p + C_V); }
        *(LAS u32x4*)(lds + row * 128 + ((ch ^ (row & 7)) << 4)) = kv;
        *(LAS u32x4*)(lds + 32768 + row * 128 + ch * 16) = vv; }
    __syncthreads();
    const int h = g * 8 + wid, q = lane & 31, hi = lane >> 5;
    const float slope2 = exp2f(-(float)(h + 1) * 0.25f) * LOG2E, sink2 = sinks[h] * LOG2E;
    constexpr float SC2 = 0.125f * LOG2E;
    for (int a = 0; a < 4; ++a) {
        bf16_t* qp = proj + (size_t)(tok0 + 32 * a + q) * PP + C_Q + h * 64;
        bf16x8 qf[4];
#pragma unroll
        for (int ds = 0; ds < 4; ++ds) qf[ds] = *(const bf16x8*)(qp + 16 * ds + 8 * hi);
        f32x16 s[5];
#pragma unroll
        for (int kt = 0; kt < 5; ++kt) { const int key = 32 * (a + kt) + q; f32x16 acc;
#pragma unroll
            for (int r = 0; r < 16; ++r) acc[r] = 0.f;
#pragma unroll
            for (int ds = 0; ds < 4; ++ds) { const bf16x8 kf = *(const LAS bf16x8*)(lds + key * 128 + (((2 * ds + hi) ^ (key & 7)) << 4)); acc = __builtin_amdgcn_mfma_f32_32x32x16_bf16(kf, qf[ds], acc, 0, 0, 0); }
            s[kt] = acc; __builtin_amdgcn_sched_barrier(0); }
        float mx = sink2;
        int qm = q - 4 * hi; asm volatile("" : "+v"(qm));
        const float tl = -slope2 * (float)(128 + qm);
#pragma unroll
        for (int kt = 0; kt < 5; ++kt) { const bool tile_ok = (qb > 0) || (a + kt >= 4);
#pragma unroll
            for (int r = 0; r < 16; ++r) { const int cc0 = (r & 3) + 8 * (r >> 2);
                bool valid = tile_ok;
                if (kt == 0) valid = valid && (cc0 > qm);
                if (kt == 4) valid = valid && (cc0 <= qm);
                const float v = valid ? fmaf(slope2, (float)(32 * kt + cc0), fmaf(s[kt][r], SC2, tl)) : -INFINITY; s[kt][r] = v; mx = fmaxf(mx, v); } }
        mx = fmaxf(mx, __shfl_xor(mx, 32));
        float sum = 0.f;
#pragma unroll
        for (int kt = 0; kt < 5; ++kt)
#pragma unroll
            for (int r = 0; r < 16; ++r) { const float p = fast_exp2(s[kt][r] - mx); s[kt][r] = p; sum += p; }
        sum += __shfl_xor(sum, 32);
        const float inv = 1.0f / (sum + fast_exp2(sink2 - mx));
        f32x16 o[2];
#pragma unroll
        for (int r = 0; r < 16; ++r) { o[0][r] = 0.f; o[1][r] = 0.f; }
#pragma unroll
        for (int kt = 0; kt < 5; ++kt)
#pragma unroll
            for (int s2 = 0; s2 < 2; ++s2) {
                u32x4 pw; pw.x = cvt_pk_bf16(s[kt][8 * s2 + 0], s[kt][8 * s2 + 1]); pw.y = cvt_pk_bf16(s[kt][8 * s2 + 2], s[kt][8 * s2 + 3]); pw.z = cvt_pk_bf16(s[kt][8 * s2 + 4], s[kt][8 * s2 + 5]); pw.w = cvt_pk_bf16(s[kt][8 * s2 + 6], s[kt][8 * s2 + 7]);
                const bf16x8 pa = __builtin_bit_cast(bf16x8, pw);
                const int keybase = 32 * (a + kt) + 16 * s2 + 4 * hi;
#pragma unroll
                for (int dt = 0; dt < 2; ++dt) {
                    LAS unsigned char* vp = lds + 32768 + (keybase + ((lane & 15) >> 2)) * 128 + (32 * dt + 16 * ((lane >> 4) & 1) + 4 * (lane & 3)) * 2;
                    const s16x4 lo = __builtin_amdgcn_ds_read_tr16_b64_v4i16((LAS s16x4*)vp), hh = __builtin_amdgcn_ds_read_tr16_b64_v4i16((LAS s16x4*)(vp + 8 * 128));
                    const bf16x8 vf = (bf16x8){lo[0], lo[1], lo[2], lo[3], hh[0], hh[1], hh[2], hh[3]};
                    o[dt] = __builtin_amdgcn_mfma_f32_32x32x16_bf16(vf, pa, o[dt], 0, 0, 0); } __builtin_amdgcn_sched_barrier(0); }
#pragma unroll
        for (int dt = 0; dt < 2; ++dt)
#pragma unroll
            for (int rq = 0; rq < 4; ++rq) { u32x2 w; w.x = cvt_pk_bf16(o[dt][4 * rq] * inv, o[dt][4 * rq + 1] * inv); w.y = cvt_pk_bf16(o[dt][4 * rq + 2] * inv, o[dt][4 * rq + 3] * inv);
                *(u32x2*)(qp + 32 * dt + 8 * rq + 4 * hi) = w; }
    }
}

constexpr int RW_BYTES = 11776, RROW = 336, R_WA = 94208, R_WI = 104960, R_CW = 115712, R_XX = 118912;
__device__ __forceinline__ void rnn_unit(LAS unsigned char* lds, bf16_t* proj, const bf16_t* wat, const bf16_t* wit, const Args& A, int unit, int tid, int wid, int lane) {
    asm volatile("" : "+v"(tid), "+v"(lane));
    const int cgp = unit % 5, n = (unit / 5) % 16, b = unit / 80;
    const int co = lane & 31, hi = lane >> 5, chl = cgp * 32 + co, chg = n * 160 + chl;
    LAS unsigned char* Rw = lds + wid * RW_BYTES;
    LAS float* cwl = (LAS float*)(lds + R_CW);
    LAS float* xx = (LAS float*)(lds + R_XX);
    __syncthreads();
    for (int i = tid; i < 800; i += NTHREADS) cwl[i] = (i < 640) ? A.rnn_conv_w[(size_t)(i / 160) * DRNN + n * 160 + (i % 160)] : A.rnn_conv_b[n * 160 + (i - 640)];
    for (int i = tid; i < 2 * 32 * 20; i += NTHREADS) { const int which = i / 640, e = i % 640, o = e / 20, c = e % 20;
        const u32x4 v = *(const u32x4*)((which ? wit : wat) + ((size_t)(n * 160 + cgp * 32 + o)) * 160 + c * 8);
        *(LAS u32x4*)(lds + (which ? R_WI : R_WA) + o * RROW + c * 16) = v; }
    const float cba = A.lru_ba[chg], cbi = A.lru_bi[chg];
    const float lam = A.lru_lambda[chg];
    const float c2 = -8.0f * LOG2E * (fmaxf(-lam, 0.f) + log1pf(expf(-fabsf(lam))));
    __syncthreads();
    float C = 0.f;
    const int cc = (lane < 60) ? (lane % 20) : 0, tp = (lane < 60) ? (lane / 20) : 3;
    for (int ss = 0; ss < 8; ++ss) {
        const int T0 = ss * 256 + wid * 32; const size_t grow0 = (size_t)b * SEQ + T0;
        unsigned ryo = (unsigned)(((unsigned)grow0 + 4u * hi) * PP + C_RY + chg) * 2u; asm volatile("" : "+v"(ryo));
        unsigned short ryv[16];
#pragma unroll
        for (int r = 0; r < 16; ++r) ryv[r] = *(const unsigned short*)((const char*)proj + (ryo + (unsigned)(((r & 3) + 8 * (r >> 2)) * PP * 2)));
#pragma unroll
        for (int i = 0; i < 11; ++i) { const int idx = lane + 64 * i; if (idx < 700) { const int row = idx / 20, c = idx % 20, T = T0 - 3 + row;
                u32x4 v = (u32x4){0u, 0u, 0u, 0u}; if (T >= 0) v = *(const u32x4*)((const char*)proj + (unsigned)(((unsigned)(b * SEQ + T)) * PP + C_RX + n * 160 + c * 8) * 2u);
                *(LAS u32x4*)(Rw + row * RROW + c * 16) = v; } }
        {
            f32x4 wk[4][2], bbv[2];
#pragma unroll
            for (int k = 0; k < 4; ++k) { wk[k][0] = *(const LAS f32x4*)(cwl + k * 160 + 8 * cc); wk[k][1] = *(const LAS f32x4*)(cwl + k * 160 + 8 * cc + 4); }
            bbv[0] = *(const LAS f32x4*)(cwl + 640 + 8 * cc); bbv[1] = *(const LAS f32x4*)(cwl + 640 + 8 * cc + 4);
            u32x4 outs[11];
#pragma unroll
            for (int i = 0; i < 11; ++i) { const int t = tp + 3 * i; f32x4 a0 = bbv[0], a1 = bbv[1];
                if (t < 32 && tp < 3) {
#pragma unroll
                    for (int k = 0; k < 4; ++k) { const u32x4 rv = *(const LAS u32x4*)(Rw + (t + k) * RROW + cc * 16);
                        a0[0] += wk[k][0][0] * bflo(rv.x); a0[1] += wk[k][0][1] * bfhi(rv.x); a0[2] += wk[k][0][2] * bflo(rv.y); a0[3] += wk[k][0][3] * bfhi(rv.y);
                        a1[0] += wk[k][1][0] * bflo(rv.z); a1[1] += wk[k][1][1] * bfhi(rv.z); a1[2] += wk[k][1][2] * bflo(rv.w); a1[3] += wk[k][1][3] * bfhi(rv.w); } }
                outs[i].x = cvt_pk_bf16(a0[0], a0[1]); outs[i].y = cvt_pk_bf16(a0[2], a0[3]); outs[i].z = cvt_pk_bf16(a1[0], a1[1]); outs[i].w = cvt_pk_bf16(a1[2], a1[3]); }
            asm volatile("s_waitcnt lgkmcnt(0)" ::: "memory");
#pragma unroll
            for (int i = 0; i < 11; ++i) { const int t = tp + 3 * i; if (t < 32 && tp < 3) *(LAS u32x4*)(Rw + (t + 3) * RROW + cc * 16) = outs[i]; }
        }
        f32x16 ga, gi;
#pragma unroll
        for (int r = 0; r < 16; ++r) { ga[r] = 0.f; gi[r] = 0.f; }
#pragma unroll
        for (int ks = 0; ks < 10; ++ks) { const bf16x8 xa = *(const LAS bf16x8*)(Rw + (co + 3) * RROW + (16 * ks + 8 * hi) * 2);
            const bf16x8 wa = *(const LAS bf16x8*)(lds + R_WA + co * RROW + (16 * ks + 8 * hi) * 2), wi = *(const LAS bf16x8*)(lds + R_WI + co * RROW + (16 * ks + 8 * hi) * 2);
            ga = __builtin_amdgcn_mfma_f32_32x32x16_bf16(xa, wa, ga, 0, 0, 0); gi = __builtin_amdgcn_mfma_f32_32x32x16_bf16(xa, wi, gi, 0, 0, 0); }
        float hl[16], ca[16], Ae[4], He[4];
#pragma unroll
        for (int rq = 0; rq < 4; ++rq) { float hacc = 0.f, aacc = 1.f;
#pragma unroll
            for (int j = 0; j < 4; ++j) { const int r = 4 * rq + j;
                const float xcv = bf2f(*(const LAS unsigned short*)(Rw + (crow(r, hi) + 3) * RROW + chl * 2));
                const float rr = sigmoidf_(ga[r] + cba), ii = sigmoidf_(gi[r] + cbi);
                const float av = fast_exp2(c2 * rr);
                const float uu = sqrtf(fmaxf(1.0f - av * av, 0.f)) * (ii * xcv);
                hacc = av * hacc + uu; aacc *= av; hl[r] = hacc; ca[r] = aacc; }
            Ae[rq] = aacc; He[rq] = hacc; }
        float cin[4], ast[4]; float cc_ = 0.f, aa_ = 1.f;
#pragma unroll
        for (int rq = 0; rq < 4; ++rq) { const float pA = __shfl_xor(Ae[rq], 32), pH = __shfl_xor(He[rq], 32);
            const float A0 = hi ? pA : Ae[rq], H0 = hi ? pH : He[rq], A1 = hi ? Ae[rq] : pA, H1 = hi ? He[rq] : pH;
            const float c_after0 = A0 * cc_ + H0, a_after0 = aa_ * A0;
            cin[rq] = hi ? c_after0 : cc_; ast[rq] = hi ? a_after0 : aa_;
            cc_ = A1 * c_after0 + H1; aa_ = a_after0 * A1; }
        LAS float* xs = xx + (ss & 1) * 512;
        if (hi == 0) { xs[(wid * 32 + co) * 2] = aa_; xs[(wid * 32 + co) * 2 + 1] = cc_; }
        __syncthreads();
        float cw_in = C, crun = C;
#pragma unroll
        for (int v = 0; v < 8; ++v) { const float av = xs[(v * 32 + co) * 2], hv = xs[(v * 32 + co) * 2 + 1]; if (v == wid) cw_in = crun; crun = av * crun + hv; }
        C = crun;
#pragma unroll
        for (int r = 0; r < 16; ++r) { const int rq = r >> 2;
            const float h0 = hl[r] + ca[r] * cin[rq];
            const float hh = h0 + (ca[r] * ast[rq]) * cw_in;
            const float y = hh * gelu_tanh(bf2f(ryv[r]));
            *(unsigned short*)((char*)proj + (ryo + (unsigned)(((r & 3) + 8 * (r >> 2)) * PP * 2))) = (unsigned short)(cvt_pk_bf16(y, 0.f) & 0xffffu); }
    }
}

__device__ __forceinline__ void ln_rows(float* h, bf16_t* hb, const float* gam, const float* bet, int gw, int NGW, int lane) {
    for (int row = gw; row < M; row += NGW) {
        f32x4* p = (f32x4*)(h + (size_t)row * DM) + lane;
        f32x4 v[8]; float s = 0.f;
#pragma unroll
        for (int j = 0; j < 8; ++j) { v[j] = p[64 * j]; s += (v[j][0] + v[j][1]) + (v[j][2] + v[j][3]); }
#pragma unroll
        for (int o = 1; o < 64; o <<= 1) s += __shfl_xor(s, o);
        const float mean = s * (1.0f / DM); float s2 = 0.f;
#pragma unroll
        for (int j = 0; j < 8; ++j) { v[j] = v[j] - mean; s2 += (v[j][0] * v[j][0] + v[j][1] * v[j][1]) + (v[j][2] * v[j][2] + v[j][3] * v[j][3]); }
#pragma unroll
        for (int o = 1; o < 64; o <<= 1) s2 += __shfl_xor(s2, o);
        const float rstd = 1.0f / sqrtf(s2 * (1.0f / DM) + LN_EPS);
#pragma unroll
        for (int j = 0; j < 8; ++j) { const f32x4 gg = *((const f32x4*)gam + lane + 64 * j), bb = *((const f32x4*)bet + lane + 64 * j);
            const f32x4 y = v[j] * rstd * gg + bb; p[64 * j] = y;
            if (hb) { u32x2 w; w.x = cvt_pk_bf16(y[0], y[1]); w.y = cvt_pk_bf16(y[2], y[3]); *((u32x2*)(hb + (size_t)row * DM) + lane + 64 * j) = w; } }
    }
}

#define XB_TMO      128
#define XB_XCNT(j)  (256  + 64 * (j))
#define XB_XSUB(j)  (1280 + 64 * (j))
#define XB_XGEN(j)  (2304 + 64 * (j))
#define XB_TOP      3328
#define XB_TOPGEN   3392
#define XCD_BAR_WORDS 3456
#define XB_SPIN_CAP (1u << 18)
__device__ __forceinline__ unsigned xb_ld(unsigned* p)              { return __hip_atomic_load(p, __ATOMIC_RELAXED, __HIP_MEMORY_SCOPE_AGENT); }
__device__ __forceinline__ unsigned xb_add(unsigned* p, unsigned v) { return __hip_atomic_fetch_add(p, v, __ATOMIC_RELAXED, __HIP_MEMORY_SCOPE_AGENT); }
__device__ __forceinline__ unsigned xb_xcc_id() { return (unsigned)__builtin_amdgcn_s_getreg((3 << 11) | 20) & 0xFu; }
#define XB_SPIN(cond, bar) do { unsigned _sp = 0; while (cond) { __builtin_amdgcn_s_sleep(1); \
    if ((++_sp & 255u) == 0u) { if (xb_ld(&(bar)[XB_TMO])) break; if (_sp > XB_SPIN_CAP) { atomicAdd(&(bar)[XB_TMO], 1u); break; } } } } while (0)
struct XcdBarrier { unsigned* bar; unsigned x; volatile LAS unsigned* st; };
__device__ __forceinline__ XcdBarrier xcd_barrier_post(unsigned* bar, volatile LAS unsigned* st) {
    XcdBarrier b; b.bar = bar; b.x = xb_xcc_id(); b.st = st;
    if (threadIdx.x == 0) (void)xb_add(&bar[XB_XCNT(b.x)], 1u);
    return b;
}
__device__ __forceinline__ void xcd_barrier_complete(unsigned* bar, unsigned x, unsigned& nloc, unsigned& nx) {
    const unsigned G = gridDim.x * gridDim.y * gridDim.z;
    unsigned sum, cnt, mine, sp = 0u;
    for (;;) {
        sum = 0u; cnt = 0u; mine = 0u;
#pragma unroll
        for (unsigned j = 0; j < 16; ++j) { const unsigned c = xb_ld(&bar[XB_XCNT(j)]); sum += c; cnt += (c > 0u) ? 1u : 0u; mine = (j == x) ? c : mine; }
        if (sum == G) break;
        __builtin_amdgcn_s_sleep(1);
        if ((++sp & 255u) == 0u) { if (xb_ld(&bar[XB_TMO])) break; if (sp > XB_SPIN_CAP) { atomicAdd(&bar[XB_TMO], 1u); break; } }
    }
    nloc = mine > 0u ? mine : 1u; nx = cnt > 0u ? cnt : 1u;
}
__device__ __forceinline__ void xcd_barrier(const XcdBarrier& b) {
    asm volatile("s_waitcnt vmcnt(0)" ::: "memory");
    __syncthreads();
    if (threadIdx.x == 0) {
        unsigned* bar = b.bar;
        __builtin_amdgcn_s_waitcnt(0);
        unsigned nloc = b.st[0], nx = b.st[1];
        if (nloc == 0u) { xcd_barrier_complete(bar, b.x, nloc, nx); b.st[0] = nloc; b.st[1] = nx; }
        const unsigned old = xb_add(&bar[XB_XSUB(b.x)], 1u);
        const unsigned gen = old / nloc;
        if (old + 1u == (gen + 1u) * nloc) {
            __builtin_amdgcn_fence(__ATOMIC_RELEASE, "agent");
            asm volatile("s_waitcnt vmcnt(0)" ::: "memory");
            const unsigned og = xb_add(&bar[XB_TOP], 1u);
            const unsigned tg = og / nx;
            if (og + 1u == (tg + 1u) * nx) xb_add(&bar[XB_TOPGEN], 1u);
            else XB_SPIN(xb_ld(&bar[XB_TOPGEN]) == tg, bar);
            __builtin_amdgcn_fence(__ATOMIC_ACQUIRE, "agent");
            xb_add(&bar[XB_XGEN(b.x)], 1u);
            asm volatile("s_waitcnt vmcnt(0)" ::: "memory");
        } else {
            XB_SPIN(xb_ld(&bar[XB_XGEN(b.x)]) == gen, bar);
            __builtin_amdgcn_fence(__ATOMIC_ACQUIRE, "agent");
            asm volatile("s_waitcnt vmcnt(0)" ::: "memory");
        }
    }
    __syncthreads();
}

__global__ void __launch_bounds__(NTHREADS, 2) fwd_kernel(Args a) {
    extern __shared__ __attribute__((aligned(16))) unsigned char lds_raw[];
    LAS unsigned char* lds = (LAS unsigned char*)lds_raw;
    cg::grid_group grid = cg::this_grid();
    const int tid = threadIdx.x, lane = tid & 63, wid = __builtin_amdgcn_readfirstlane(tid >> 6);
    const int G = gridDim.x, bx = blockIdx.x;
    const int gw = bx * NWAVES + wid, NGW = G * NWAVES, gtid = bx * NTHREADS + tid, NGT = G * NTHREADS;
    unsigned char* ws = a.ws;
    bf16_t* wat = (bf16_t*)(ws + WS_LRU); bf16_t* wit = wat + 16 * 160 * 160;
    bf16_t* win = (bf16_t*)(ws + WS_WIN); bf16_t* wcat = (bf16_t*)(ws + WS_WCAT); bf16_t* wout = (bf16_t*)(ws + WS_WOUT); bf16_t* wug = (bf16_t*)(ws + WS_WUG); bf16_t* wdn = (bf16_t*)(ws + WS_WDN);
    bf16_t* xb = (bf16_t*)(ws + WS_XB); bf16_t* proj = (bf16_t*)(ws + WS_PROJ); bf16_t* act = proj;
    bf16_t* gate = (bf16_t*)a.out;
    float* gtail = (float*)(ws + WS_STASH); float* ghead = gtail + 64 * 2 * DFF; float* uhead = ghead + 64 * 2 * DFF;
    const int lo = a.ph_lo, hi = a.ph_hi;
    volatile LAS unsigned* xst = (volatile LAS unsigned*)(lds + XLDS_OFF + 15360);
    if (tid < 4) xst[tid] = 0u;
    __syncthreads();
    const XcdBarrier xbar = xcd_barrier_post((unsigned*)ws, xst);
#ifndef PH2_MASK
#define PH2_MASK 3
#endif
#ifndef PH_MASK
#define PH_MASK 0x3ff
#endif
#define IN(k) (((PH_MASK >> (k)) & 1) && lo <= (k) && (k) < hi)
#define SEAM(k) do { if (IN(k) && IN((k) + 1)) { if ((k) == 0) grid.sync(); else xcd_barrier(xbar); } } while (0)

    if (IN(0)) prologue(a, lds, gw, NGW, wid, lane, gtid, NGT);
    SEAM(0);
    if (IN(1)) { pg8::Gemm g{xb, win, DM, DM, DM}; pg8::StaticOrder S; S.init(M, DIN, G, bx); pg8::EpiProj E{proj, gate, a.b_gate}; pg8::gemm_phase(lds, g, S, E); }
    SEAM(1);
    if (IN(2)) {
        for (int it = bx; it < 640 + 512; it += G) { if (it < 640) { if (PH2_MASK & 1) rnn_unit(lds, proj, wat, wit, a, it, tid, wid, lane); } else { if (PH2_MASK & 2) attn_unit(lds, proj, a.attn_sinks, it - 640, tid, wid, lane); } }
    }
    SEAM(2);
    if (IN(3)) { pg8::Gemm g{proj, wcat, PP, KCAT, KCAT}; pg8::StaticOrder S; S.init(M, DM, G, bx); pg8::EpiMerge E{gate, xb, 32}; pg8::gemm_phase(lds, g, S, E); }
    SEAM(3);
    if (IN(4)) { pg8::Gemm g{xb, wout, DM, DM, DM}; pg8::StaticOrder S; S.init(M, DM, G, bx); pg8::EpiRes E{a.x, a.out}; pg8::gemm_phase(lds, g, S, E); }
    SEAM(4);
    if (IN(5)) ln_rows(a.out, xb, a.ln1_g, a.ln1_b, gw, NGW, lane);
    SEAM(5);
    if (IN(6)) { pg8::Gemm g{xb, wug, DM, DM, DM}; pg8::StaticOrder S; S.init(M, 2 * DFF, G, bx); pg8::EpiGlu E{act, a.ffn_conv_w, a.ffn_conv_b, gtail, ghead, uhead}; pg8::gemm_phase(lds, g, S, E); }
    SEAM(6);
    if (IN(7)) {
        for (int i = gtid; i < 64 * 2 * DFF; i += NGT) { const int pm = i / (2 * DFF), rr = (i / DFF) & 1, ch = i % DFF;
            if ((pm & 7) == 0) continue;
            const float t0 = gtail[((size_t)(pm - 1) * 2 + 0) * DFF + ch], t1 = gtail[((size_t)(pm - 1) * 2 + 1) * DFF + ch], h0 = ghead[((size_t)pm * 2 + 0) * DFF + ch], h1 = ghead[((size_t)pm * 2 + 1) * DFF + ch];
            const float w0 = a.ffn_conv_w[ch], w1 = a.ffn_conv_w[DFF + ch], w2 = a.ffn_conv_w[2 * DFF + ch], bb = a.ffn_conv_b[ch];
            const float cv = rr ? (w0 * t1 + w1 * h0 + w2 * h1 + bb) : (w0 * t0 + w1 * t1 + w2 * h0 + bb);
            const float y = gelu_tanh(cv) * uhead[((size_t)pm * 2 + rr) * DFF + ch];
            act[(size_t)(pm * 256 + rr) * DFF + ch] = (bf16_t)(cvt_pk_bf16(y, 0.f) & 0xffffu); }
    }
    SEAM(7);
    if (IN(8)) { pg8::Gemm g{act, wdn, DFF, DFF, DFF}; pg8::StaticOrder S; S.init(M, DM, G, bx); pg8::EpiRes E{a.out, a.out}; pg8::gemm_phase(lds, g, S, E); }
    SEAM(8);
    if (IN(9)) ln_rows(a.out, nullptr, a.ln2_g, a.ln2_b, gw, NGW, lane);
#undef IN
#undef SEAM
}

#ifndef MK_PER_PHASE
#define MK_PER_PHASE 0
#endif
extern "C" void kernel_launch(void* const* d_in, const int* in_sizes, int n_in, void* d_out, int out_size, void* d_ws, size_t ws_size, hipStream_t stream) {
    static int grid = 0;
    if (grid == 0) {
        if (n_in != 23 || out_size != M * DM || ws_size < WS_END) { fprintf(stderr, "kernel_launch: unexpected problem: n_in %d out %d ws %zu\n", n_in, out_size, ws_size); grid = -1; return; }
        int dev = 0, cus = 0, per_cu = 0;
        hipGetDevice(&dev); hipDeviceGetAttribute(&cus, hipDeviceAttributeMultiprocessorCount, dev);
        hipFuncSetAttribute((const void*)fwd_kernel, hipFuncAttributeMaxDynamicSharedMemorySize, LDS_BYTES);
        hipOccupancyMaxActiveBlocksPerMultiprocessor(&per_cu, (const void*)fwd_kernel, NTHREADS, LDS_BYTES);
        if (per_cu < 1) { fprintf(stderr, "kernel_launch: occupancy query says %d blocks/CU\n", per_cu); per_cu = 1; }
        (void)hipGetLastError();
        grid = cus;
    }
    if (grid < 0) return;
    if (hipMemsetAsync(d_ws, 0, 16384, stream) != hipSuccess) { fprintf(stderr, "kernel_launch: memset of the barrier words failed\n"); return; }
    Args a{};
    const float** f = (const float**)&a;
    for (int i = 0; i < 23; ++i) f[i] = (const float*)d_in[i];
    a.out = (float*)d_out; a.ws = (unsigned char*)d_ws;
#if MK_PER_PHASE
    for (int p = 0; p < 10; ++p) { a.ph_lo = p; a.ph_hi = p + 1; hipLaunchKernelGGL(fwd_kernel, dim3(grid), dim3(NTHREADS), LDS_BYTES, stream, a); }
#else
    a.ph_lo = 0; a.ph_hi = 10;
    void* args[] = {&a};
    hipError_t e = hipLaunchCooperativeKernel((const void*)fwd_kernel, dim3(grid), dim3(NTHREADS), args, LDS_BYTES, stream);
    if (e != hipSuccess) fprintf(stderr, "cooperative launch failed: %s (grid %d)\n", hipGetErrorString(e), grid);
#endif
}
```
